# Optimizing an MI355X kernel written in HIP

```python
import math
import jax
import jax.numpy as jnp
from jax import lax
import numpy as np

D_MODEL = 1024
BATCH = 32
SEQ = 2048
DEPTH = 1
DEC_BATCH = 16
DEC_SEQ = 16
PAST_LEN = 2048

CHUNK = 64
A_PAST_CHUNKS = 8
A_BAND = A_PAST_CHUNKS + 1
A_REACH = A_PAST_CHUNKS * CHUNK
N_HEADS_A = 8
HEAD_DIM_A = 64
WIDTH_A = N_HEADS_A * HEAD_DIM_A
REL_CLIP = 128
N_HEADS_B = 4
HEAD_DIM_B = 128
WIDTH_B = N_HEADS_B * HEAD_DIM_B
CONV_W = 4
B_CONV_DIM = 3 * WIDTH_B
N_HEADS_X = 4
HEAD_DIM_X = D_MODEL // N_HEADS_X
N_MEM = 256
D_FF = 2816
EPS = 1e-6
OFF_A = 0
OFF_B = OFF_A + 3 * WIDTH_A
OFF_Z = OFF_B + B_CONV_DIM
OFF_BETA = OFF_Z + WIDTH_B
OFF_DECAY = OFF_BETA + N_HEADS_B
OFF_GATE = OFF_DECAY + N_HEADS_B
N_IN = OFF_GATE + 2 * D_MODEL

kernel_name = 'hybrid_stream_band_attn_gated_delta_step'


def rmsnorm(x, g):
    xf = x.astype(jnp.float32)
    y = xf * lax.rsqrt(jnp.mean(xf * xf, axis=-1, keepdims=True) + EPS)
    return (y * g.astype(jnp.float32)).astype(x.dtype)


def l2norm(x):
    xf = x.astype(jnp.float32)
    return (xf * lax.rsqrt(jnp.sum(xf * xf, axis=-1, keepdims=True) + EPS)).astype(x.dtype)


def swiglu_ffn(x, g, w_gate, w_up, w_down):
    h = rmsnorm(x, g)
    return (jax.nn.silu(h @ w_gate) * (h @ w_up)) @ w_down


def rel_bias(table, d):
    idx = jnp.clip(d, -REL_CLIP, REL_CLIP) + REL_CLIP
    return table[:, idx].astype(jnp.float32)


def band_attention_prompt(q, k, v, table):
    bsz, s, h, dh = q.shape
    nc = s // CHUNK
    pad = ((0, 0), (A_REACH, 0), (0, 0), (0, 0))
    kp = jnp.pad(k, pad)
    vp = jnp.pad(v, pad)
    krel = jnp.arange(A_BAND * CHUNK) - A_REACH
    qrel = jnp.arange(CHUNK)
    bias = rel_bias(table, qrel[:, None] - krel[None, :])
    scale = HEAD_DIM_A ** -0.5

    def one_chunk(c):
        start = c * CHUNK
        qc = lax.dynamic_slice_in_dim(q, start, CHUNK, axis=1)
        kb = lax.dynamic_slice_in_dim(kp, start, A_BAND * CHUNK, axis=1)
        vb = lax.dynamic_slice_in_dim(vp, start, A_BAND * CHUNK, axis=1)
        sc = jnp.einsum('bqhd,bkhd->bhqk', qc, kb).astype(jnp.float32) * scale + bias
        valid = (start + krel) >= 0
        sc = jnp.where(valid[None, None, None, :], sc, -jnp.inf)
        p = jax.nn.softmax(sc, axis=-1).astype(v.dtype)
        return jnp.einsum('bhqk,bkhd->bqhd', p, vb)

    out = lax.map(one_chunk, jnp.arange(nc))
    return out.transpose(1, 0, 2, 3, 4).reshape(bsz, s, h, dh)


def band_attention_sample(q, k_new, v_new, k_cache, v_cache, table):
    t = q.shape[1]
    p_len = k_cache.shape[1]
    kk = jnp.concatenate([k_cache, k_new], axis=1)
    vv = jnp.concatenate([v_cache, v_new], axis=1)
    kpos = jnp.concatenate([jnp.arange(-p_len, 0), jnp.arange(t)])
    bias = rel_bias(table, jnp.arange(t)[:, None] - kpos[None, :])
    sc = jnp.einsum('bqhd,bkhd->bhqk', q, kk).astype(jnp.float32) * (HEAD_DIM_A ** -0.5) + bias
    p = jax.nn.softmax(sc, axis=-1).astype(vv.dtype)
    return jnp.einsum('bhqk,bkhd->bqhd', p, vv)


def causal_conv(x, prev, w):
    t = x.shape[1]
    xp = jnp.concatenate([prev, x], axis=1)
    y = xp[:, 0:t] * w[0]
    for j in range(1, CONV_W):
        y = y + xp[:, j:j + t] * w[j]
    return jax.nn.silu(y), xp[:, -(CONV_W - 1):]


def gated_delta_rule(q, k, v, g, beta, s0, blk):
    bsz, t, h, dk = q.shape
    dv = v.shape[-1]
    n = t // blk
    f32 = jnp.float32

    def blocks(a):
        return a.astype(f32).reshape(bsz, n, blk, h, -1).transpose(1, 0, 3, 2, 4)

    qc, kc, vc = blocks(q), blocks(k), blocks(v)
    gc = jnp.cumsum(blocks(g[..., None])[..., 0], axis=-1)
    bc = blocks(beta[..., None])[..., 0]
    incl = jnp.tril(jnp.ones((blk, blk), bool))
    strict = jnp.tril(jnp.ones((blk, blk), bool), -1)
    decay = jnp.exp(jnp.where(incl, gc[..., :, None] - gc[..., None, :], -jnp.inf))
    kbeta = kc * bc[..., None]
    a_mat = jnp.where(strict, jnp.einsum('nbhid,nbhjd->nbhij', kbeta, kc) * decay, 0.0) + jnp.eye(blk, dtype=f32)
    rhs = jnp.concatenate([vc * bc[..., None], kbeta * jnp.exp(gc)[..., None]], axis=-1)
    sol = lax.linalg.triangular_solve(a_mat, rhs, left_side=True, lower=True, unit_diagonal=True)
    u, w = sol[..., :dv], sol[..., dv:]
    intra = jnp.einsum('nbhid,nbhjd->nbhij', qc, kc) * decay
    qg = qc * jnp.exp(gc)[..., None]
    kdec = kc * jnp.exp(gc[..., -1:] - gc)[..., None]
    glast = jnp.exp(gc[..., -1])

    def step(s, xs):
        u_n, w_n, qg_n, intra_n, kdec_n, gl_n = xs
        v_n = u_n - jnp.einsum('bhlk,bhkv->bhlv', w_n, s)
        o = jnp.einsum('bhlk,bhkv->bhlv', qg_n, s) + jnp.einsum('bhij,bhjv->bhiv', intra_n, v_n)
        s = s * gl_n[..., None, None] + jnp.einsum('bhlk,bhlv->bhkv', kdec_n, v_n)
        return s, o

    s_fin, o = lax.scan(step, s0.astype(f32), (u, w, qg, intra, kdec, glast))
    o = o.transpose(1, 0, 3, 2, 4).reshape(bsz, t, h, dv)
    return o.astype(v.dtype), s_fin.astype(s0.dtype)


def token_mixers(h, lp, a_k_cache, a_v_cache, conv_prev, s0):
    bsz, t, _ = h.shape
    proj = h @ lp['w_in']

    def heads(cols, nh, hd):
        return cols.reshape(bsz, t, nh, hd)

    qa = heads(proj[..., OFF_A:OFF_A + WIDTH_A], N_HEADS_A, HEAD_DIM_A)
    ka = heads(proj[..., OFF_A + WIDTH_A:OFF_A + 2 * WIDTH_A], N_HEADS_A, HEAD_DIM_A)
    va = heads(proj[..., OFF_A + 2 * WIDTH_A:OFF_B], N_HEADS_A, HEAD_DIM_A)
    if a_k_cache is None:
        ya = band_attention_prompt(qa, ka, va, lp['a_rel_bias'])
        keep = min(A_REACH, t)
        new_k, new_v = ka[:, t - keep:], va[:, t - keep:]
    else:
        ya = band_attention_sample(qa, ka, va, a_k_cache, a_v_cache, lp['a_rel_bias'])
        new_k, new_v = ka, va
    xb, new_conv = causal_conv(proj[..., OFF_B:OFF_Z], conv_prev, lp['b_conv_w'])
    qb = l2norm(heads(xb[..., :WIDTH_B], N_HEADS_B, HEAD_DIM_B)) * (HEAD_DIM_B ** -0.5)
    kb = l2norm(heads(xb[..., WIDTH_B:2 * WIDTH_B], N_HEADS_B, HEAD_DIM_B))
    vb = heads(xb[..., 2 * WIDTH_B:], N_HEADS_B, HEAD_DIM_B)
    zb = heads(proj[..., OFF_Z:OFF_BETA], N_HEADS_B, HEAD_DIM_B)
    beta = jax.nn.sigmoid(proj[..., OFF_BETA:OFF_DECAY].astype(jnp.float32))
    decay_in = proj[..., OFF_DECAY:OFF_GATE].astype(jnp.float32) + lp['b_dt_bias'].astype(jnp.float32)
    g = -jnp.exp(lp['b_a_log'].astype(jnp.float32)) * jax.nn.softplus(decay_in)
    ob, new_s = gated_delta_rule(qb, kb, vb, g, beta, s0, min(CHUNK, t))
    ob = rmsnorm(ob, lp['b_out_norm']) * jax.nn.silu(zb)
    gate = jax.nn.sigmoid(proj[..., OFF_GATE:])
    merged = (gate[..., :D_MODEL] * (ya.reshape(bsz, t, WIDTH_A) @ lp['w_branch_a'])
              + gate[..., D_MODEL:] * (ob.reshape(bsz, t, WIDTH_B) @ lp['w_branch_b']))
    return merged @ lp['w_mix_out'], new_k, new_v, new_conv, new_s


def memory_kv(mem, g, wk, wv):
    m = rmsnorm(mem, g)
    bsz = mem.shape[0]
    mk = (m @ wk).reshape(bsz, N_MEM, N_HEADS_X, HEAD_DIM_X)
    mv = (m @ wv).reshape(bsz, N_MEM, N_HEADS_X, HEAD_DIM_X)
    return mk, mv


def cross_attention(x, g, wq, wo, mk, mv):
    bsz, t, _ = x.shape
    q = (rmsnorm(x, g) @ wq).reshape(bsz, t, N_HEADS_X, HEAD_DIM_X)
    sc = jnp.einsum('bqhd,bkhd->bhqk', q, mk).astype(jnp.float32) * (HEAD_DIM_X ** -0.5)
    p = jax.nn.softmax(sc, axis=-1).astype(mv.dtype)
    o = jnp.einsum('bhqk,bkhd->bqhd', p, mv).reshape(bsz, t, D_MODEL)
    return o @ wo


def trunk_layer(x, lp, mem_k, mem_v, a_k_cache, a_v_cache, conv_prev, s0):
    x = x + 0.5 * swiglu_ffn(x, lp['ffn1_norm'], lp['ffn1_w_gate'], lp['ffn1_w_up'], lp['ffn1_w_down'])
    mix, new_k, new_v, new_conv, new_s = token_mixers(rmsnorm(x, lp['mix_norm']), lp, a_k_cache, a_v_cache, conv_prev, s0)
    x = x + mix
    x = x + cross_attention(x, lp['xattn_norm'], lp['xattn_wq'], lp['xattn_wo'], mem_k, mem_v)
    x = x + 0.5 * swiglu_ffn(x, lp['ffn2_norm'], lp['ffn2_w_gate'], lp['ffn2_w_up'], lp['ffn2_w_down'])
    return x, new_k, new_v, new_conv, new_s


def setup_inputs(seed: int = 0) -> dict:
    key = jax.random.key(seed)
    keys = list(jax.random.split(key, 40))

    def nrm(shape, scale=1.0):
        return scale * jax.random.normal(keys.pop(), shape, jnp.float32)

    def gain(shape):
        return 1.0 + nrm(shape, 0.05)

    L = DEPTH
    a_len = min(A_REACH, PAST_LEN)
    dt = jnp.exp(jax.random.uniform(keys.pop(), (L, N_HEADS_B), jnp.float32, math.log(1e-3), math.log(1e-1)))
    a_init = jax.random.uniform(keys.pop(), (L, N_HEADS_B), jnp.float32, 1.0, 16.0)
    return {
        'x_prompt': nrm((BATCH, SEQ, D_MODEL)),
        'x_sample': nrm((DEC_BATCH, DEC_SEQ, D_MODEL)),
        'cache_a_k': nrm((L, DEC_BATCH, a_len, N_HEADS_A, HEAD_DIM_A)),
        'cache_a_v': nrm((L, DEC_BATCH, a_len, N_HEADS_A, HEAD_DIM_A)),
        'state_b_conv': nrm((L, DEC_BATCH, CONV_W - 1, B_CONV_DIM)),
        'state_b_s': nrm((L, DEC_BATCH, N_HEADS_B, HEAD_DIM_B, HEAD_DIM_B), 0.1),
        'cache_mem_k': nrm((L, DEC_BATCH, N_MEM, N_HEADS_X, HEAD_DIM_X)),
        'cache_mem_v': nrm((L, DEC_BATCH, N_MEM, N_HEADS_X, HEAD_DIM_X)),
        'mem_prompt': nrm((BATCH, N_MEM, D_MODEL)),
        'ffn1_norm': gain((L, D_MODEL)),
        'ffn1_w_gate': nrm((L, D_MODEL, D_FF), D_MODEL ** -0.5),
        'ffn1_w_up': nrm((L, D_MODEL, D_FF), D_MODEL ** -0.5),
        'ffn1_w_down': nrm((L, D_FF, D_MODEL), D_FF ** -0.5),
        'mix_norm': gain((L, D_MODEL)),
        'w_in': nrm((L, D_MODEL, N_IN), D_MODEL ** -0.5),
        'a_rel_bias': nrm((L, N_HEADS_A, 2 * REL_CLIP + 1), 0.5),
        'b_conv_w': nrm((L, CONV_W, B_CONV_DIM), CONV_W ** -0.5),
        'b_a_log': jnp.log(a_init),
        'b_dt_bias': dt + jnp.log(-jnp.expm1(-dt)),
        'b_out_norm': gain((L, HEAD_DIM_B)),
        'w_branch_a': nrm((L, WIDTH_A, D_MODEL), WIDTH_A ** -0.5),
        'w_branch_b': nrm((L, WIDTH_B, D_MODEL), WIDTH_B ** -0.5),
        'w_mix_out': nrm((L, D_MODEL, D_MODEL), D_MODEL ** -0.5),
        'xattn_norm': gain((L, D_MODEL)),
        'mem_norm': gain((L, D_MODEL)),
        'xattn_wq': nrm((L, D_MODEL, D_MODEL), D_MODEL ** -0.5),
        'xattn_wk': nrm((L, D_MODEL, D_MODEL), D_MODEL ** -0.5),
        'xattn_wv': nrm((L, D_MODEL, D_MODEL), D_MODEL ** -0.5),
        'xattn_wo': nrm((L, D_MODEL, D_MODEL), D_MODEL ** -0.5),
        'ffn2_norm': gain((L, D_MODEL)),
        'ffn2_w_gate': nrm((L, D_MODEL, D_FF), D_MODEL ** -0.5),
        'ffn2_w_up': nrm((L, D_MODEL, D_FF), D_MODEL ** -0.5),
        'ffn2_w_down': nrm((L, D_FF, D_MODEL), D_FF ** -0.5),
        'final_norm': gain((D_MODEL,)),
    }


def reference(x_prompt, x_sample, cache_a_k, cache_a_v, state_b_conv, state_b_s, cache_mem_k, cache_mem_v,
              mem_prompt, ffn1_norm, ffn1_w_gate, ffn1_w_up, ffn1_w_down, mix_norm, w_in, a_rel_bias,
              b_conv_w, b_a_log, b_dt_bias, b_out_norm, w_branch_a, w_branch_b, w_mix_out, xattn_norm,
              mem_norm, xattn_wq, xattn_wk, xattn_wv, xattn_wo, ffn2_norm, ffn2_w_gate, ffn2_w_up,
              ffn2_w_down, final_norm):
    xp, xs = x_prompt, x_sample
    bp = x_prompt.shape[0]
    p_a_k, p_a_v, p_b_conv, p_b_s, p_mem_k, p_mem_v = [], [], [], [], [], []
    s_a_k, s_a_v, s_b_conv, s_b_s = [], [], [], []
    for l in range(DEPTH):
        lp = {
            'ffn1_norm': ffn1_norm[l], 'ffn1_w_gate': ffn1_w_gate[l], 'ffn1_w_up': ffn1_w_up[l],
            'ffn1_w_down': ffn1_w_down[l], 'mix_norm': mix_norm[l], 'w_in': w_in[l],
            'a_rel_bias': a_rel_bias[l], 'b_conv_w': b_conv_w[l], 'b_a_log': b_a_log[l],
            'b_dt_bias': b_dt_bias[l], 'b_out_norm': b_out_norm[l], 'w_branch_a': w_branch_a[l],
            'w_branch_b': w_branch_b[l], 'w_mix_out': w_mix_out[l], 'xattn_norm': xattn_norm[l],
            'xattn_wq': xattn_wq[l], 'xattn_wo': xattn_wo[l], 'ffn2_norm': ffn2_norm[l],
            'ffn2_w_gate': ffn2_w_gate[l], 'ffn2_w_up': ffn2_w_up[l], 'ffn2_w_down': ffn2_w_down[l],
        }
        mk_p, mv_p = memory_kv(mem_prompt, mem_norm[l], xattn_wk[l], xattn_wv[l])
        conv0 = jnp.zeros((bp, CONV_W - 1, B_CONV_DIM), x_prompt.dtype)
        s_zero = jnp.zeros((bp, N_HEADS_B, HEAD_DIM_B, HEAD_DIM_B), x_prompt.dtype)
        xp, ak, av, cv, sb = trunk_layer(xp, lp, mk_p, mv_p, None, None, conv0, s_zero)
        p_a_k.append(ak)
        p_a_v.append(av)
        p_b_conv.append(cv)
        p_b_s.append(sb)
        p_mem_k.append(mk_p)
        p_mem_v.append(mv_p)
        xs, ak, av, cv, sb = trunk_layer(xs, lp, cache_mem_k[l], cache_mem_v[l], cache_a_k[l], cache_a_v[l],
                                         state_b_conv[l], state_b_s[l])
        s_a_k.append(ak)
        s_a_v.append(av)
        s_b_conv.append(cv)
        s_b_s.append(sb)
    y_prompt = rmsnorm(xp, final_norm)
    y_sample = rmsnorm(xs, final_norm)
    return (y_prompt, y_sample,
            jnp.stack(p_a_k), jnp.stack(p_a_v), jnp.stack(p_b_conv), jnp.stack(p_b_s),
            jnp.stack(p_mem_k), jnp.stack(p_mem_v),
            jnp.stack(s_a_k), jnp.stack(s_a_v), jnp.stack(s_b_conv), jnp.stack(s_b_s))
```

```cpp
#include <hip/hip_runtime.h>
#include <hip/hip_cooperative_groups.h>
#include <cstdio>
#include <cstdint>
namespace cg = cooperative_groups;

#define DI __device__ __forceinline__
typedef float f32x16 __attribute__((ext_vector_type(16)));
typedef unsigned u32x2 __attribute__((ext_vector_type(2)));

namespace pg8 {
#define PG8_LAS __attribute__((address_space(3)))
typedef unsigned short bf16_t;
typedef short bf16x8 __attribute__((ext_vector_type(8)));
typedef float f32x4 __attribute__((ext_vector_type(4)));
typedef unsigned u32x4 __attribute__((ext_vector_type(4)));
constexpr int BM = 256, BK = 64, HALF = 128, HTB = HALF * BK * 2  , STAGE_BYTES = 8 * HTB, NXCD = 8, WGM = 8;

__host__ __device__ __forceinline__ int lds_byte(int r, int c) { const int st = (r >> 4) * 2 + (c >> 5), rr = r & 15, cc = c & 31, ob = rr * 64 + cc * 2; return st * 1024 + (ob ^ (((ob >> 9) & 1) << 5)); }
__host__ __device__ __forceinline__ void stage_rc(int b, int& R, int& C) { const int st = b / 1024, sb = b % 1024, swz = sb ^ (((sb >> 9) & 1) << 5); R = (st >> 1) * 16 + swz / 64; C = (st & 1) * 32 + (swz % 64) / 2; }
__host__ __device__ __forceinline__ int perm32(int rho) { const int n = rho >> 4, i = rho & 15; return 8 * (i >> 2) + 4 * n + (i & 3); }

struct Unit { int pm, pn; };
struct Gemm { const bf16_t* A; const bf16_t* Bt; int M, N, K, lda; };

struct StaticOrder {
    int nM, nN, nwg, G, c;
    __host__ __device__ void init(int M, int N, int G_, int c_) { nM = M / BM; nN = N / BM; nwg = nM * nN; G = G_; c = c_; }
    __host__ __device__ bool next(int i, Unit& u) const {
        const long L = (long)i * G + c; if (L >= nwg) return false;
        int wgid = (int)L; { const int q = nwg / NXCD, r = nwg % NXCD, xcd = wgid % NXCD, off = wgid / NXCD; wgid = (xcd < r ? xcd * (q + 1) : r * (q + 1) + (xcd - r) * q) + off; }
        const int nig = WGM * nN, gid = wgid / nig, fm = gid * WGM, gsz = (nM - fm) < WGM ? (nM - fm) : WGM;
        u.pm = fm + ((wgid % nig) % gsz); u.pn = (wgid % nig) / gsz; return true;
    }
    __device__ __forceinline__ void a_ready(const Unit&) const {}
    __device__ __forceinline__ void done(const Unit&) const {}
};


__device__ __forceinline__ unsigned cvt_pk_bf16(float lo, float hi) { unsigned r; asm("v_cvt_pk_bf16_f32 %0, %1, %2" : "=v"(r) : "v"(lo), "v"(hi)); return r; }
__device__ __forceinline__ float bflo(unsigned u) { return __uint_as_float(u << 16); }
__device__ __forceinline__ float bfhi(unsigned u) { return __uint_as_float(u & 0xffff0000u); }
__device__ __forceinline__ float rstd16(const float* ss, int row) {
    const f32x4* p = (const f32x4*)(ss + (size_t)row * 16);
    const f32x4 a = p[0], b = p[1], c = p[2], d = p[3];
    const float s = (((a[0] + a[1]) + (a[2] + a[3])) + ((b[0] + b[1]) + (b[2] + b[3]))) + (((c[0] + c[1]) + (c[2] + c[3])) + ((d[0] + d[1]) + (d[2] + d[3])));
    return rsqrtf(s * (1.0f / 1024.0f) + 1e-6f);
}
__device__ __forceinline__ float silu_f(float g) { return g * __builtin_amdgcn_rcpf(1.0f + __expf(-g)); }
__device__ __forceinline__ float sigm_f(float g) { return __builtin_amdgcn_rcpf(1.0f + __expf(-g)); }

struct EpiSwiglu {
    static constexpr bool PERM = true, AFTER_DRAIN = false;
    bf16_t* O; int ldc; const float* ss;
    __device__ __forceinline__ void operator()(const f32x4 (&acc)[2][2][4][2], const Unit& u, int wr, int wc, int fr, int fq) const {
        const int row0 = u.pm * BM + wr * 64 + fr, col0 = u.pn * 128 + wc * 32 + 8 * fq;
#pragma unroll
        for (int ai = 0; ai < 2; ++ai)
#pragma unroll
            for (int m = 0; m < 4; ++m) {
                const int row = row0 + ai * HALF + m * 16; const float rs = rstd16(ss, row);
                float h[8];
#pragma unroll
                for (int n = 0; n < 2; ++n)
#pragma unroll
                    for (int j = 0; j < 4; ++j) { const float g = acc[ai][0][m][n][j] * rs, up = acc[ai][1][m][n][j] * rs; h[4 * n + j] = silu_f(g) * up; }
                u32x4 w; w.x = cvt_pk_bf16(h[0], h[1]); w.y = cvt_pk_bf16(h[2], h[3]); w.z = cvt_pk_bf16(h[4], h[5]); w.w = cvt_pk_bf16(h[6], h[7]);
                *(u32x4*)(O + (size_t)row * ldc + col0) = w;
            }
    }
};
struct EpiScale {
    static constexpr bool PERM = true, AFTER_DRAIN = false;
    bf16_t* O; int ldc; const float* ss; float cs;
    __device__ __forceinline__ void operator()(const f32x4 (&acc)[2][2][4][2], const Unit& u, int wr, int wc, int fr, int fq) const {
        const int row0 = u.pm * BM + wr * 64 + fr, col0 = u.pn * BM + wc * 32 + 8 * fq;
#pragma unroll
        for (int ai = 0; ai < 2; ++ai)
#pragma unroll
            for (int m = 0; m < 4; ++m) {
                const int row = row0 + ai * HALF + m * 16; const float rs = (ss ? rstd16(ss, row) : 1.0f) * cs;
#pragma unroll
                for (int bj = 0; bj < 2; ++bj) { const f32x4 v0 = acc[ai][bj][m][0] * rs, v1 = acc[ai][bj][m][1] * rs;
                    u32x4 w; w.x = cvt_pk_bf16(v0[0], v0[1]); w.y = cvt_pk_bf16(v0[2], v0[3]); w.z = cvt_pk_bf16(v1[0], v1[1]); w.w = cvt_pk_bf16(v1[2], v1[3]);
                    *(u32x4*)(O + (size_t)row * ldc + col0 + bj * HALF) = w; }
            }
    }
};
struct EpiRes {
    static constexpr bool PERM = false, AFTER_DRAIN = false;
    const float* srcP; const float* srcS; float* dst; bf16_t* xb; float* ssout; float alpha;
    __device__ __forceinline__ void operator()(const f32x4 (&acc)[2][2][4][2], const Unit& u, int wr, int wc, int fr, int fq) const {
        const int row0 = u.pm * BM + wr * 64 + fr, col0 = u.pn * BM + wc * 32 + 4 * fq;
#pragma unroll
        for (int ai = 0; ai < 2; ++ai)
#pragma unroll
            for (int m = 0; m < 4; ++m) {
                const int row = row0 + ai * HALF + m * 16;
                const float* sp = (row < 65536) ? srcP + (size_t)row * 1024 : srcS + (size_t)(row - 65536) * 1024;
                float s = 0.f;
#pragma unroll
                for (int bj = 0; bj < 2; ++bj)
#pragma unroll
                    for (int n = 0; n < 2; ++n) {
                        const int col = col0 + bj * HALF + n * 16;
                        const f32x4 xo = *(const f32x4*)(sp + col);
                        const f32x4 v = xo + acc[ai][bj][m][n] * alpha;
                        *(f32x4*)(dst + (size_t)row * 1024 + col) = v;
                        s += (v[0] * v[0] + v[1] * v[1]) + (v[2] * v[2] + v[3] * v[3]);
                        if (xb) { u32x2 w; w.x = cvt_pk_bf16(v[0], v[1]); w.y = cvt_pk_bf16(v[2], v[3]); *(u32x2*)(xb + (size_t)row * 1024 + col) = w; }
                    }
                s += __shfl_xor(s, 16); s += __shfl_xor(s, 32);
                if (fq == 0) ssout[(size_t)row * 16 + u.pn * 4 + wc] = s;
            }
    }
};
struct EpiMemKV {
    static constexpr bool PERM = false, AFTER_DRAIN = false;
    float* outK; float* outV; bf16_t* kb; bf16_t* vb; const float* ssm;
    __device__ __forceinline__ void operator()(const f32x4 (&acc)[2][2][4][2], const Unit& u, int wr, int wc, int fr, int fq) const {
        const int row0 = u.pm * BM + wr * 64 + fr; const bool isv = u.pn >= 4; const int col0 = (u.pn & 3) * BM + wc * 32 + 4 * fq;
        float* of = isv ? outV : outK; bf16_t* ob = isv ? vb : kb;
#pragma unroll
        for (int ai = 0; ai < 2; ++ai)
#pragma unroll
            for (int m = 0; m < 4; ++m) {
                const int row = row0 + ai * HALF + m * 16; const float rs = rsqrtf(ssm[row] * (1.0f / 1024.0f) + 1e-6f);
#pragma unroll
                for (int bj = 0; bj < 2; ++bj)
#pragma unroll
                    for (int n = 0; n < 2; ++n) {
                        const int col = col0 + bj * HALF + n * 16; const f32x4 v = acc[ai][bj][m][n] * rs;
                        *(f32x4*)(of + (size_t)row * 1024 + col) = v;
                        u32x2 w; w.x = cvt_pk_bf16(v[0], v[1]); w.y = cvt_pk_bf16(v[2], v[3]); *(u32x2*)(ob + (size_t)row * 1024 + col) = w;
                    }
            }
    }
};
template <int PASS> struct EpiBranch {
    static constexpr bool PERM = true, AFTER_DRAIN = false;
    bf16_t* proj; int gcol;
    __device__ __forceinline__ void operator()(const f32x4 (&acc)[2][2][4][2], const Unit& u, int wr, int wc, int fr, int fq) const {
        const int row0 = u.pm * BM + wr * 64 + fr, col0 = u.pn * BM + wc * 32 + 8 * fq;
#pragma unroll
        for (int ai = 0; ai < 2; ++ai)
#pragma unroll
            for (int m = 0; m < 4; ++m) {
                bf16_t* rp = proj + (size_t)(row0 + ai * HALF + m * 16) * 5632;
#pragma unroll
                for (int bj = 0; bj < 2; ++bj) {
                    const int c = col0 + bj * HALF;
                    const u32x4 gv = *(const u32x4*)(rp + gcol + c);
                    float o[8];
                    o[0] = sigm_f(bflo(gv.x)) * acc[ai][bj][m][0][0]; o[1] = sigm_f(bfhi(gv.x)) * acc[ai][bj][m][0][1];
                    o[2] = sigm_f(bflo(gv.y)) * acc[ai][bj][m][0][2]; o[3] = sigm_f(bfhi(gv.y)) * acc[ai][bj][m][0][3];
                    o[4] = sigm_f(bflo(gv.z)) * acc[ai][bj][m][1][0]; o[5] = sigm_f(bfhi(gv.z)) * acc[ai][bj][m][1][1];
                    o[6] = sigm_f(bflo(gv.w)) * acc[ai][bj][m][1][2]; o[7] = sigm_f(bfhi(gv.w)) * acc[ai][bj][m][1][3];
                    if (PASS == 1) { const u32x4 tv = *(const u32x4*)(rp + 512 + c);
                        o[0] += bflo(tv.x); o[1] += bfhi(tv.x); o[2] += bflo(tv.y); o[3] += bfhi(tv.y); o[4] += bflo(tv.z); o[5] += bfhi(tv.z); o[6] += bflo(tv.w); o[7] += bfhi(tv.w); }
                    u32x4 w; w.x = cvt_pk_bf16(o[0], o[1]); w.y = cvt_pk_bf16(o[2], o[3]); w.z = cvt_pk_bf16(o[4], o[5]); w.w = cvt_pk_bf16(o[6], o[7]);
                    *(u32x4*)(rp + 512 + c) = w;
                }
            }
    }
};

template <class Epi, class Sched, bool ALIGN_EPI = false, bool SP2 = false>
__device__ __forceinline__ void gemm_phase(PG8_LAS unsigned char* lds, const Gemm g, const Sched& S, const Epi& E) {
    int tid_l = threadIdx.x; asm volatile("" : "+v"(tid_l));
    const int tid = tid_l, wid = __builtin_amdgcn_readfirstlane(tid >> 6), lane = tid & 63, wr = wid >> 2, wc = wid & 3, fr = lane & 15, fq = lane >> 4;
    const int K = g.K, nt = K / BK;
    unsigned voffA[2], voffB[2];
#pragma unroll
    for (int i = 0; i < 2; ++i) { int R, C; stage_rc(tid * 16 + i * 8192, R, C); const int Rb = Epi::PERM ? ((R & ~31) + perm32(R & 31)) : R;
        voffA[i] = (unsigned)(R * g.lda + C) * 2u; voffB[i] = (unsigned)(Rb * K + C) * 2u; }
    const size_t kstep = (size_t)(BK * 2);
    const size_t hstep = (size_t)HALF * K * 2;
    const size_t tstep = 2 * hstep; const size_t hstepA = (size_t)HALF * g.lda * 2, tstepA = 2 * hstepA;
    const unsigned ldsw = (unsigned)wid * 1024u;
    const int aoff = lds_byte(wr * 64 + fr, fq * 8), boff = lds_byte(wc * 32 + fr, fq * 8);
#define PG8_SA(b, h) (((b) * 2 + (h)) * HTB)
#define PG8_SB(b, h) ((4 + (b) * 2 + (h)) * HTB)
#define PG8_STAGE(bufoff, gbase, voff) do { _Pragma("unroll") for (int _i = 0; _i < 2; ++_i) \
        __builtin_amdgcn_global_load_lds((const unsigned*)((const char*)(gbase) + (voff)[_i]), (PG8_LAS unsigned*)(lds + (bufoff) + ldsw + _i * 8192), 16, 0, 0); } while (0)
#define PG8_LDA(dst, b, h) do { _Pragma("unroll") for (int m = 0; m < 4; ++m) _Pragma("unroll") for (int k = 0; k < 2; ++k) dst[m][k] = *(const PG8_LAS bf16x8*)(lds + PG8_SA(b, h) + aoff + m * 2048 + k * 1024); } while (0)
#define PG8_LDB(dst, b, h) do { _Pragma("unroll") for (int n = 0; n < 2; ++n) _Pragma("unroll") for (int k = 0; k < 2; ++k) dst[n][k] = *(const PG8_LAS bf16x8*)(lds + PG8_SB(b, h) + boff + n * 2048 + k * 1024); } while (0)
#define PG8_MMA(ai, bj, At, Bt) do { __builtin_amdgcn_s_setprio(1); _Pragma("unroll") for (int m = 0; m < 4; ++m) _Pragma("unroll") for (int n = 0; n < 2; ++n) _Pragma("unroll") for (int k = 0; k < 2; ++k) \
        acc[ai][bj][m][n] = __builtin_amdgcn_mfma_f32_16x16x32_bf16(Bt[n][k], At[m][k], acc[ai][bj][m][n], 0, 0, 0); __builtin_amdgcn_s_setprio(0); } while (0)
#define PG8_WAIT_V(n) asm volatile("s_waitcnt vmcnt(" #n ")" ::: "memory")
#define PG8_WAIT_L(n) asm volatile("s_waitcnt lgkmcnt(" #n ")" ::: "memory")
#define PG8_BAR __builtin_amdgcn_s_barrier()
#define PG8_SCHED __builtin_amdgcn_sched_barrier(0)
    Unit cur, nxt; int ui = 0;
    if (!S.next(0, cur)) return;
    f32x4 acc[2][2][4][2];
#pragma unroll
    for (int a = 0; a < 2; ++a)
#pragma unroll
        for (int b = 0; b < 2; ++b)
#pragma unroll
            for (int m = 0; m < 4; ++m)
#pragma unroll
                for (int n = 0; n < 2; ++n) acc[a][b][m][n] = (f32x4){0.f, 0.f, 0.f, 0.f};
    bf16x8 At[4][2], B0[2][2], B1[2][2];
    const char* cA = (const char*)g.A + (size_t)cur.pm * tstepA; const char* cB = (const char*)g.Bt + (size_t)cur.pn * tstep;
    S.a_ready(cur);
    if constexpr (SP2) {
        PG8_STAGE(PG8_SB(0, 0), cB, voffB); PG8_STAGE(PG8_SB(0, 1), cB + hstep, voffB); PG8_STAGE(PG8_SA(0, 0), cA, voffA); PG8_STAGE(PG8_SA(0, 1), cA + hstepA, voffA);
        if (wr == 1) PG8_BAR;
        PG8_WAIT_V(2); PG8_BAR;
        PG8_STAGE(PG8_SB(1, 0), cB + kstep, voffB); PG8_STAGE(PG8_SA(1, 0), cA + kstep, voffA); PG8_STAGE(PG8_SB(1, 1), cB + hstep + kstep, voffB);
        PG8_WAIT_V(6); PG8_BAR;
    } else {
        PG8_STAGE(PG8_SB(0, 0), cB, voffB); PG8_STAGE(PG8_SA(0, 0), cA, voffA); PG8_STAGE(PG8_SB(0, 1), cB + hstep, voffB); PG8_STAGE(PG8_SA(0, 1), cA + hstepA, voffA);
        if (wr == 1) PG8_BAR;
        PG8_WAIT_V(4); PG8_BAR;
        PG8_STAGE(PG8_SB(1, 0), cB + kstep, voffB); PG8_STAGE(PG8_SA(1, 0), cA + kstep, voffA); PG8_STAGE(PG8_SB(1, 1), cB + hstep + kstep, voffB);
        PG8_WAIT_V(6); PG8_BAR;
    }
    for (;;) {
        const bool has_next = S.next(ui + 1, nxt);
        const char* nA = has_next ? (const char*)g.A + (size_t)nxt.pm * tstepA : cA; const char* nB = has_next ? (const char*)g.Bt + (size_t)nxt.pn * tstep : cB;
        for (int t = 0; t < nt; t += 2) {
            const bool last = (t == nt - 2);
            const char* a1 = cA + (size_t)(t + 1) * kstep;
            const char* a2 = last ? nA : cA + (size_t)(t + 2) * kstep; const char* b2 = last ? nB : cB + (size_t)(t + 2) * kstep;
            const char* a3 = a2 + kstep; const char* b3 = b2 + kstep;
            if (last && has_next) S.a_ready(nxt);
            if constexpr (SP2) {
            PG8_LDB(B0, 0, 0); PG8_LDB(B1, 0, 1); PG8_SCHED; PG8_LDA(At, 0, 0); PG8_STAGE(PG8_SA(1, 1), a1 + hstepA, voffA);
            PG8_WAIT_V(8); PG8_WAIT_L(0); PG8_BAR; PG8_MMA(0, 0, At, B0); PG8_MMA(0, 1, At, B1); PG8_BAR; PG8_SCHED;
            PG8_LDA(At, 0, 1); PG8_STAGE(PG8_SB(0, 0), b2, voffB); PG8_STAGE(PG8_SB(0, 1), b2 + hstep, voffB); PG8_STAGE(PG8_SA(0, 0), a2, voffA);
            PG8_WAIT_V(8); PG8_WAIT_L(0); PG8_BAR; PG8_MMA(1, 0, At, B0); PG8_MMA(1, 1, At, B1); PG8_BAR; PG8_SCHED;
            PG8_LDB(B0, 1, 0); PG8_LDB(B1, 1, 1); PG8_SCHED; PG8_LDA(At, 1, 0); PG8_STAGE(PG8_SA(0, 1), a2 + hstepA, voffA);
            PG8_WAIT_V(8); PG8_WAIT_L(0); PG8_BAR; PG8_MMA(0, 0, At, B0); PG8_MMA(0, 1, At, B1); PG8_BAR; PG8_SCHED;
            PG8_LDA(At, 1, 1); PG8_STAGE(PG8_SB(1, 0), b3, voffB); PG8_STAGE(PG8_SB(1, 1), b3 + hstep, voffB); PG8_STAGE(PG8_SA(1, 0), a3, voffA);
            PG8_WAIT_V(8); PG8_WAIT_L(0); PG8_BAR; PG8_MMA(1, 0, At, B0); PG8_MMA(1, 1, At, B1); PG8_BAR; PG8_SCHED;
            } else {
            PG8_LDB(B0, 0, 0); PG8_SCHED; PG8_LDA(At, 0, 0); PG8_STAGE(PG8_SA(1, 1), a1 + hstepA, voffA);
            PG8_WAIT_L(8); PG8_BAR; PG8_WAIT_L(0); PG8_MMA(0, 0, At, B0); PG8_BAR; PG8_SCHED;
            PG8_LDB(B1, 0, 1); PG8_STAGE(PG8_SB(0, 0), b2, voffB);
            PG8_BAR; PG8_WAIT_L(0); PG8_MMA(0, 1, At, B1); PG8_BAR;
            PG8_LDA(At, 0, 1); PG8_STAGE(PG8_SA(0, 0), a2, voffA);
            PG8_BAR; PG8_WAIT_L(0); PG8_MMA(1, 0, At, B0); PG8_BAR; PG8_SCHED;
            PG8_STAGE(PG8_SB(0, 1), b2 + hstep, voffB);
            PG8_WAIT_V(6); PG8_BAR; PG8_MMA(1, 1, At, B1); PG8_BAR;
            PG8_LDB(B0, 1, 0); PG8_SCHED; PG8_LDA(At, 1, 0); PG8_STAGE(PG8_SA(0, 1), a2 + hstepA, voffA);
            PG8_WAIT_L(8); PG8_BAR; PG8_WAIT_L(0); PG8_MMA(0, 0, At, B0); PG8_BAR; PG8_SCHED;
            PG8_LDB(B1, 1, 1); PG8_STAGE(PG8_SB(1, 0), b3, voffB);
            PG8_BAR; PG8_WAIT_L(0); PG8_MMA(0, 1, At, B1); PG8_BAR;
            PG8_LDA(At, 1, 1); PG8_STAGE(PG8_SA(1, 0), a3, voffA);
            PG8_BAR; PG8_WAIT_L(0); PG8_MMA(1, 0, At, B0); PG8_BAR; PG8_SCHED;
            PG8_STAGE(PG8_SB(1, 1), b3 + hstep, voffB);
            PG8_WAIT_V(6); PG8_BAR; PG8_MMA(1, 1, At, B1); PG8_BAR;
            }
        }
        if constexpr (ALIGN_EPI) { if (wr == 0) PG8_BAR; }
        if constexpr (!Epi::AFTER_DRAIN) { E(acc, cur, wr, wc, fr, fq); S.done(cur); }
        if (!has_next) break;
#pragma unroll
        for (int a = 0; a < 2; ++a)
#pragma unroll
            for (int b = 0; b < 2; ++b)
#pragma unroll
                for (int m = 0; m < 4; ++m)
#pragma unroll
                    for (int n = 0; n < 2; ++n) acc[a][b][m][n] = (f32x4){0.f, 0.f, 0.f, 0.f};
        cur = nxt; cA = nA; cB = nB; ++ui;
        if constexpr (ALIGN_EPI) { if (wr == 1) PG8_BAR; }
    }
    PG8_WAIT_V(0);
    if constexpr (!ALIGN_EPI) { if (wr == 0) PG8_BAR; }
    PG8_BAR;
    if constexpr (Epi::AFTER_DRAIN) { E.fused(acc, cur, wr, wc, fr, fq, lds, wid, lane); S.done(cur); }
#undef PG8_SA
#undef PG8_SB
#undef PG8_STAGE
#undef PG8_LDA
#undef PG8_LDB
#undef PG8_MMA
#undef PG8_WAIT_V
#undef PG8_WAIT_L
#undef PG8_BAR
#undef PG8_SCHED
}
}

using pg8::bf16_t; using pg8::bf16x8; using pg8::f32x4; using pg8::u32x4; using pg8::cvt_pk_bf16; using pg8::bflo; using pg8::bfhi; using pg8::silu_f; using pg8::sigm_f;
constexpr int MP = 65536, MS = 256, MT = MP + MS;
constexpr int DM = 1024, DFF = 2816, NPJ = 5632, NIN = 5640;
constexpr size_t MiB = 1u << 20;
constexpr size_t WS_CTL = 0;
constexpr size_t WS_WGU1 = 1 * MiB, WS_WD1 = 13 * MiB, WS_WIN = 19 * MiB, WS_WBA = 31 * MiB, WS_WBB = 32 * MiB, WS_WMIX = 33 * MiB, WS_WQ = 35 * MiB, WS_WO = 37 * MiB,
                 WS_WKV = 39 * MiB, WS_WGU2 = 43 * MiB, WS_WD2 = 55 * MiB;
constexpr size_t WS_SS = 65 * MiB, SS_STRIDE = 5 * MiB;
constexpr size_t WS_SSM = 90 * MiB;
constexpr size_t WS_BD = 91 * MiB;
constexpr size_t WS_MEMB = 94 * MiB;
constexpr size_t WS_MEMK = 110 * MiB, WS_MEMV = 134 * MiB;
constexpr size_t WS_XB = 158 * MiB;
constexpr size_t WS_BIG = 287 * MiB;
constexpr size_t WS_QX = WS_BIG, WS_OX = WS_BIG + 160 * MiB;
constexpr size_t WS_END = WS_BIG + 708 * MiB;
constexpr size_t O_Y = 0, O_PAK = (size_t)MT * DM, O_PAV = O_PAK + 8388608, O_PBC = O_PAV + 8388608, O_PBS = O_PBC + 147456, O_PMK = O_PBS + 2097152, O_PMV = O_PMK + 8388608,
                 O_SAK = O_PMV + 8388608, O_SAV = O_SAK + 131072, O_SBC = O_SAV + 131072, O_SBS = O_SBC + 73728, O_END = O_SBS + 1048576;
constexpr int LDS_BYTES = 163840;
constexpr int NT = 512;

struct Prm { const float* in[34]; float* out; unsigned char* ws; };

DI float dpp_ror(float v, int) { return v; }
#define DPP_ROR(v, n) __builtin_bit_cast(float, __builtin_amdgcn_update_dpp(0, __builtin_bit_cast(int, (v)), 0x120 + (n), 0xf, 0xf, false))
DI float wave_sum(float v) {
    v += DPP_ROR(v, 8); v += DPP_ROR(v, 4); v += DPP_ROR(v, 2); v += DPP_ROR(v, 1);
    const int iv = __builtin_bit_cast(int, v);
    const float a = __builtin_bit_cast(float, __builtin_amdgcn_readlane(iv, 0)), b = __builtin_bit_cast(float, __builtin_amdgcn_readlane(iv, 16));
    const float c = __builtin_bit_cast(float, __builtin_amdgcn_readlane(iv, 32)), d = __builtin_bit_cast(float, __builtin_amdgcn_readlane(iv, 48));
    return (a + b) + (c + d);
}
DI float bf2f(bf16_t h) { return __uint_as_float((unsigned)h << 16); }
#define MFMA32(a, b, c) __builtin_amdgcn_mfma_f32_32x32x16_bf16((a), (b), (c), 0, 0, 0)
DI int crow(int r, int h) { return (r & 3) + 8 * (r >> 2) + 4 * h; }
DI bf16x8 pack8(const f32x16& p, int s) {
    u32x4 w; w.x = cvt_pk_bf16(p[8 * s + 0], p[8 * s + 1]); w.y = cvt_pk_bf16(p[8 * s + 2], p[8 * s + 3]); w.z = cvt_pk_bf16(p[8 * s + 4], p[8 * s + 5]); w.w = cvt_pk_bf16(p[8 * s + 6], p[8 * s + 7]);
    return __builtin_bit_cast(bf16x8, w);
}
DI int kslot(int kk) { return 8 * ((kk >> 2) & 1) + 4 * (kk >> 3) + (kk & 3); }

DI void tr_item(const float* Wc, int ld, const float* gain, int k0, bf16_t* dst, int K, float* scr, int lane) {
#pragma unroll 8
    for (int i = 0; i < 32; ++i) { const int kk = 2 * i + (lane >> 5); float v = Wc[(size_t)(k0 + kk) * ld + (lane & 31)]; if (gain) v *= gain[k0 + kk]; scr[kk * 33 + (lane & 31)] = v; }
    __builtin_amdgcn_wave_barrier(); asm volatile("s_waitcnt lgkmcnt(0)" ::: "memory");
    const int c = lane & 7;
#pragma unroll
    for (int j = 0; j < 4; ++j) { const int n = (lane >> 3) + 8 * j; const float* s = scr + (8 * c) * 33 + n;
        u32x4 o; o.x = cvt_pk_bf16(s[0 * 33], s[1 * 33]); o.y = cvt_pk_bf16(s[2 * 33], s[3 * 33]); o.z = cvt_pk_bf16(s[4 * 33], s[5 * 33]); o.w = cvt_pk_bf16(s[6 * 33], s[7 * 33]);
        *(u32x4*)(dst + (size_t)n * K + k0 + 8 * c) = o; }
    __builtin_amdgcn_wave_barrier(); asm volatile("s_waitcnt lgkmcnt(0)" ::: "memory");
}
DI void phase0(const Prm& p, unsigned char* lds, int wave, int lane, int gw, int NGW) {
    float* scr = (float*)(lds + wave * 16384);
    unsigned char* ws = p.ws;
    for (int it = gw; it < 14336; it += NGW) {
        int r = it;
        if (r < 2816) { const int kb = r / 176, nb = r % 176, t = nb >> 3, w = nb & 7;
            tr_item((w < 4 ? p.in[10] : p.in[11]) + 128 * t + 32 * (w & 3), DFF, p.in[9], 64 * kb, (bf16_t*)(ws + WS_WGU1) + (size_t)(32 * nb) * 1024, 1024, scr, lane); continue; } r -= 2816;
        if (r < 1408) { const int kb = r / 32, nb = r % 32;
            tr_item(p.in[12] + 32 * nb, 1024, nullptr, 64 * kb, (bf16_t*)(ws + WS_WD1) + (size_t)(32 * nb) * DFF, DFF, scr, lane); continue; } r -= 1408;
        if (r < 2816) { const int kb = r / 176, nb = r % 176, c0 = 32 * nb, sc = c0 < 3584 ? c0 : c0 + 8;
            tr_item(p.in[14] + sc, NIN, p.in[13], 64 * kb, (bf16_t*)(ws + WS_WIN) + (size_t)c0 * 1024, 1024, scr, lane); continue; } r -= 2816;
        if (r < 256) { const int kb = r / 32, nb = r % 32;
            tr_item(p.in[20] + 32 * nb, 1024, nullptr, 64 * kb, (bf16_t*)(ws + WS_WBA) + (size_t)(32 * nb) * 512, 512, scr, lane); continue; } r -= 256;
        if (r < 256) { const int kb = r / 32, nb = r % 32;
            tr_item(p.in[21] + 32 * nb, 1024, nullptr, 64 * kb, (bf16_t*)(ws + WS_WBB) + (size_t)(32 * nb) * 512, 512, scr, lane); continue; } r -= 256;
        if (r < 512) { const int kb = r / 32, nb = r % 32;
            tr_item(p.in[22] + 32 * nb, 1024, nullptr, 64 * kb, (bf16_t*)(ws + WS_WMIX) + (size_t)(32 * nb) * 1024, 1024, scr, lane); continue; } r -= 512;
        if (r < 512) { const int kb = r / 32, nb = r % 32;
            tr_item(p.in[25] + 32 * nb, 1024, p.in[23], 64 * kb, (bf16_t*)(ws + WS_WQ) + (size_t)(32 * nb) * 1024, 1024, scr, lane); continue; } r -= 512;
        if (r < 512) { const int kb = r / 32, nb = r % 32;
            tr_item(p.in[28] + 32 * nb, 1024, nullptr, 64 * kb, (bf16_t*)(ws + WS_WO) + (size_t)(32 * nb) * 1024, 1024, scr, lane); continue; } r -= 512;
        if (r < 1024) { const int kb = r / 64, nb = r % 64;
            tr_item((nb < 32 ? p.in[26] + 32 * nb : p.in[27] + 32 * (nb - 32)), 1024, p.in[24], 64 * kb, (bf16_t*)(ws + WS_WKV) + (size_t)(32 * nb) * 1024, 1024, scr, lane); continue; } r -= 1024;
        if (r < 2816) { const int kb = r / 176, nb = r % 176, t = nb >> 3, w = nb & 7;
            tr_item((w < 4 ? p.in[30] : p.in[31]) + 128 * t + 32 * (w & 3), DFF, p.in[29], 64 * kb, (bf16_t*)(ws + WS_WGU2) + (size_t)(32 * nb) * 1024, 1024, scr, lane); continue; } r -= 2816;
        { const int kb = r / 32, nb = r % 32;
            tr_item(p.in[32] + 32 * nb, 1024, nullptr, 64 * kb, (bf16_t*)(ws + WS_WD2) + (size_t)(32 * nb) * DFF, DFF, scr, lane); }
    }
    bf16_t* xb = (bf16_t*)(ws + WS_XB); float* ss0 = (float*)(ws + WS_SS);
    for (int m = gw; m < MT; m += NGW) {
        const f32x4* xr = (const f32x4*)(m < MP ? p.in[0] + (size_t)m * DM : p.in[1] + (size_t)(m - MP) * DM) + lane;
        f32x4 v[4]; float s = 0.f;
#pragma unroll
        for (int j = 0; j < 4; ++j) { v[j] = xr[64 * j]; s += (v[j][0] * v[j][0] + v[j][1] * v[j][1]) + (v[j][2] * v[j][2] + v[j][3] * v[j][3]); }
        s = wave_sum(s);
        u32x2* o = (u32x2*)(xb + (size_t)m * DM) + lane;
#pragma unroll
        for (int j = 0; j < 4; ++j) { u32x2 w; w.x = cvt_pk_bf16(v[j][0], v[j][1]); w.y = cvt_pk_bf16(v[j][2], v[j][3]); o[64 * j] = w; }
        if (lane < 16) ss0[(size_t)m * 16 + lane] = lane == 0 ? s : 0.f;
    }
    bf16_t* memb = (bf16_t*)(ws + WS_MEMB); float* ssm = (float*)(ws + WS_SSM);
    for (int m = gw; m < 8192; m += NGW) {
        const f32x4* xr = (const f32x4*)(p.in[8] + (size_t)m * DM) + lane;
        f32x4 v[4]; float s = 0.f;
#pragma unroll
        for (int j = 0; j < 4; ++j) { v[j] = xr[64 * j]; s += (v[j][0] * v[j][0] + v[j][1] * v[j][1]) + (v[j][2] * v[j][2] + v[j][3] * v[j][3]); }
        s = wave_sum(s);
        u32x2* o = (u32x2*)(memb + (size_t)m * DM) + lane;
#pragma unroll
        for (int j = 0; j < 4; ++j) { u32x2 w; w.x = cvt_pk_bf16(v[j][0], v[j][1]); w.y = cvt_pk_bf16(v[j][2], v[j][3]); o[64 * j] = w; }
        if (lane == 0) ssm[m] = s;
    }
    for (int m = gw; m < 8192; m += NGW) {
        const int which = m >> 12, r = m & 4095;
        const f32x4* xr = (const f32x4*)(p.in[6 + which] + (size_t)r * DM) + lane;
        u32x2* o = (u32x2*)((bf16_t*)(ws + (which ? WS_MEMV : WS_MEMK)) + (size_t)(8192 + r) * DM) + lane;
#pragma unroll
        for (int j = 0; j < 4; ++j) { const f32x4 v = xr[64 * j]; u32x2 w; w.x = cvt_pk_bf16(v[0], v[1]); w.y = cvt_pk_bf16(v[2], v[3]); o[64 * j] = w; }
    }
}

DI void bd_pass(const Prm& p, unsigned char* lds, int tid, int wave, int lane, int gw, int NGW) {
    float* wt = (float*)lds;
    __syncthreads();
    for (int idx = tid; idx < 8192; idx += NT) { const int k = idx >> 3, j = idx & 7; wt[j * 1024 + k] = p.in[13][k] * p.in[14][(size_t)k * NIN + 3584 + j]; }
    __syncthreads();
    const bf16_t* xb = (const bf16_t*)(p.ws + WS_XB); const float* ss1 = (const float*)(p.ws + WS_SS + SS_STRIDE); float* bd = (float*)(p.ws + WS_BD);
    float ealog4[4], dtb4[4];
#pragma unroll
    for (int j = 0; j < 4; ++j) { ealog4[j] = __expf(p.in[17][j]); dtb4[j] = p.in[18][j]; }
    for (int m = gw; m < MT; m += NGW) {
        float acc[8];
#pragma unroll
        for (int j = 0; j < 8; ++j) acc[j] = 0.f;
#pragma unroll
        for (int hf = 0; hf < 2; ++hf) {
            const int k0 = 512 * hf + 8 * lane;
            const u32x4 xv = *(const u32x4*)(xb + (size_t)m * DM + k0);
            float x[8]; x[0] = bflo(xv.x); x[1] = bfhi(xv.x); x[2] = bflo(xv.y); x[3] = bfhi(xv.y); x[4] = bflo(xv.z); x[5] = bfhi(xv.z); x[6] = bflo(xv.w); x[7] = bfhi(xv.w);
#pragma unroll
            for (int j = 0; j < 8; ++j) { const f32x4 w0 = *(const f32x4*)(wt + j * 1024 + k0), w1 = *(const f32x4*)(wt + j * 1024 + k0 + 4);
                acc[j] += (x[0] * w0[0] + x[1] * w0[1]) + (x[2] * w0[2] + x[3] * w0[3]) + (x[4] * w1[0] + x[5] * w1[1]) + (x[6] * w1[2] + x[7] * w1[3]); }
        }
#pragma unroll
        for (int j = 0; j < 8; ++j) acc[j] = wave_sum(acc[j]);
        const float rs = pg8::rstd16(ss1, m);
        f32x4 ob, og;
#pragma unroll
        for (int j = 0; j < 4; ++j) {
            const float be = acc[j] * rs, de = acc[4 + j] * rs + dtb4[j];
            const float ee = __expf(de); const float sp = de > 20.f ? de : (de < -10.f ? ee : __logf(1.0f + ee));
            ob[j] = 1.0f / (1.0f + __expf(-be)); og[j] = -ealog4[j] * sp;
        }
        if (lane == 0) { *(f32x4*)(bd + (size_t)m * 8) = ob; *(f32x4*)(bd + (size_t)m * 8 + 4) = og; }
    }
    __syncthreads();
}

DI void copy_caches(const Prm& p, int wave, int lane, int wgi, int nwg) {
    const bf16_t* proj = (const bf16_t*)(p.ws + WS_BIG); float* out = p.out;
    const int gw = wgi * 8 + wave, NGW = nwg * 8;
    for (int it = gw; it < 16384 + 256; it += NGW) {
        size_t srow; float *dk, *dv;
        if (it < 16384) { const int b = it >> 9, t = it & 511; srow = (size_t)b * 2048 + 1536 + t; dk = out + O_PAK + (size_t)it * 512; dv = out + O_PAV + (size_t)it * 512; }
        else { const int r = it - 16384; srow = (size_t)MP + r; dk = out + O_SAK + (size_t)r * 512; dv = out + O_SAV + (size_t)r * 512; }
        const bf16_t* sp = proj + srow * NPJ + 512;
        const u32x4 kv = *(const u32x4*)(sp + 8 * lane), vv = *(const u32x4*)(sp + 512 + 8 * lane);
        f32x4 a, b;
        a[0] = bflo(kv.x); a[1] = bfhi(kv.x); a[2] = bflo(kv.y); a[3] = bfhi(kv.y); b[0] = bflo(kv.z); b[1] = bfhi(kv.z); b[2] = bflo(kv.w); b[3] = bfhi(kv.w);
        *(f32x4*)(dk + 8 * lane) = a; *(f32x4*)(dk + 8 * lane + 4) = b;
        a[0] = bflo(vv.x); a[1] = bfhi(vv.x); a[2] = bflo(vv.y); a[3] = bfhi(vv.y); b[0] = bflo(vv.z); b[1] = bfhi(vv.z); b[2] = bflo(vv.w); b[3] = bfhi(vv.w);
        *(f32x4*)(dv + 8 * lane) = a; *(f32x4*)(dv + 8 * lane + 4) = b;
    }
    for (int it = gw; it < 96 + 48; it += NGW) {
        size_t srow; float* d;
        if (it < 96) { const int b = it / 3, j = it % 3; srow = (size_t)b * 2048 + 2045 + j; d = out + O_PBC + (size_t)it * 1536; }
        else { const int r = it - 96, b = r / 3, j = r % 3; srow = (size_t)MP + b * 16 + 13 + j; d = out + O_SBC + (size_t)r * 1536; }
        const bf16_t* sp = proj + srow * NPJ + 1536;
        for (int c = lane; c < 1536; c += 64) d[c] = bf2f(sp[c]);
    }
}

constexpr int DN_Q = 0, DN_K = 17408, DN_KT = 34816, DN_ST = 53248, DN_IN = 88064, DN_L = 97280, DN_U = 113664, DN_VW = 130048, DN_VEC = 148480;
DI void dn_prompt(const Prm& p, unsigned char* lds, int tid0, int wave0, int lane0, int b, int h, bool dry) {
    int tid = tid0, wave = wave0, lane = lane0;
    bf16_t* proj = (bf16_t*)(p.ws + WS_BIG); const float* bd = (const float*)(p.ws + WS_BD);
    int r32 = lane & 31, hi = lane >> 5;
    float* vec = (float*)(lds + DN_VEC);
    float cw[3][4][2];
#pragma unroll
    for (int pt = 0; pt < 3; ++pt)
#pragma unroll
        for (int j = 0; j < 4; ++j) { const float* w = p.in[16] + (size_t)j * 1536 + pt * 512 + h * 128 + 2 * lane; cw[pt][j][0] = w[0]; cw[pt][j][1] = w[1]; }
    const float gn0 = p.in[19][2 * lane], gn1 = p.in[19][2 * lane + 1];
    for (int i = tid; i < 34816 / 4; i += NT) ((unsigned*)(lds + DN_ST))[i] = 0u;
    f32x16 S0, S1;
#pragma unroll
    for (int i = 0; i < 16; ++i) { S0[i] = 0.f; S1[i] = 0.f; }
    __syncthreads();
    for (int n = 0; n < 32; ++n) {
        int zz = 0; asm volatile("" : "+s"(zz)); unsigned char* LB = lds + zz; float* VEC = (float*)(LB + DN_VEC);
#define RELAUNDER() do { asm volatile("" : "+s"(zz), "+s"(wave), "+v"(lane)); LB = lds + zz; VEC = (float*)(LB + DN_VEC); r32 = lane & 31; hi = lane >> 5; tid = wave * 64 + lane; } while (0)
        const size_t rowc = (size_t)b * 2048 + n * 64;
        const float g_t = bd[(rowc + lane) * 8 + 4 + h], be_t = bd[(rowc + lane) * 8 + h];
        float gc = g_t;
#pragma unroll
        for (int o = 1; o < 64; o <<= 1) { const float t = __shfl_up(gc, o); if (lane >= o) gc += t; }
        const float gl = __shfl(gc, 63);
        const float kdsc = __expf(gl - gc);
        if (wave == 0) { VEC[lane] = gc; VEC[64 + lane] = __expf(gc); VEC[128 + lane] = be_t; }
        RELAUNDER();
        unsigned zq[8];
#pragma unroll
        for (int i = 0; i < 8; ++i) zq[i] = *(const unsigned*)(proj + (rowc + wave * 8 + i) * NPJ + 3072 + h * 128 + 2 * lane);
        {
            float xr[3][11][2];
#pragma unroll
            for (int i = 0; i < 11; ++i) {
                const long tt = (long)n * 64 + wave * 8 + i - 3;
#pragma unroll
                for (int pt = 0; pt < 3; ++pt) {
                    unsigned u = 0u;
                    if (tt >= 0) u = *(const unsigned*)(proj + ((size_t)b * 2048 + tt) * NPJ + 1536 + pt * 512 + h * 128 + 2 * lane);
                    xr[pt][i][0] = bflo(u); xr[pt][i][1] = bfhi(u);
                }
            }
            unsigned kt0[4], kt1[4];
#pragma unroll
            for (int i = 0; i < 8; ++i) {
                const int t = wave * 8 + i;
                float y[3][2];
#pragma unroll
                for (int pt = 0; pt < 3; ++pt)
#pragma unroll
                    for (int e = 0; e < 2; ++e) { const float a = (xr[pt][i][e] * cw[pt][0][e] + xr[pt][i + 1][e] * cw[pt][1][e]) + (xr[pt][i + 2][e] * cw[pt][2][e] + xr[pt][i + 3][e] * cw[pt][3][e]); y[pt][e] = silu_f(a); }
                const float sq = wave_sum(y[0][0] * y[0][0] + y[0][1] * y[0][1]), sk = wave_sum(y[1][0] * y[1][0] + y[1][1] * y[1][1]);
                const float rq = rsqrtf(sq + 1e-6f) * 0.08838834764831845f, rk = rsqrtf(sk + 1e-6f);
                const float q0 = y[0][0] * rq, q1 = y[0][1] * rq, k0 = y[1][0] * rk, k1 = y[1][1] * rk;
                *(unsigned*)(LB + DN_Q + t * 272 + 4 * lane) = cvt_pk_bf16(q0, q1);
                *(unsigned*)(LB + DN_K + t * 272 + 4 * lane) = cvt_pk_bf16(k0, k1);
                *(unsigned*)(LB + DN_VW + t * 256 + 4 * lane) = cvt_pk_bf16(y[2][0], y[2][1]);
                const float ds = __shfl(kdsc, t);
                const unsigned pk = cvt_pk_bf16(k0 * ds, k1 * ds);
                if ((i & 1) == 0) { kt0[i >> 1] = pk & 0xffffu; kt1[i >> 1] = pk >> 16; } else { kt0[i >> 1] |= pk << 16; kt1[i >> 1] |= pk & 0xffff0000u; }
            }
            u32x4 w0, w1; w0.x = kt0[0]; w0.y = kt0[1]; w0.z = kt0[2]; w0.w = kt0[3]; w1.x = kt1[0]; w1.y = kt1[1]; w1.z = kt1[2]; w1.w = kt1[3];
            *(u32x4*)(LB + DN_KT + (2 * lane) * 144 + 16 * wave) = w0;
            *(u32x4*)(LB + DN_KT + (2 * lane + 1) * 144 + 16 * wave) = w1;
        }
        __syncthreads();
        RELAUNDER();
        {
            const int which = wave >> 2, ib = (wave >> 1) & 1, jb = wave & 1;
            f32x16 c;
#pragma unroll
            for (int i = 0; i < 16; ++i) c[i] = 0.f;
            const unsigned char* ab = LB + (which ? DN_Q : DN_K) + (32 * ib + r32) * 272 + 16 * hi;
            const unsigned char* bb = LB + DN_K + (32 * jb + r32) * 272 + 16 * hi;
#pragma unroll
            for (int s = 0; s < 8; ++s) c = MFMA32(*(const bf16x8*)(ab + 32 * s), *(const bf16x8*)(bb + 32 * s), c);
            const int j = 32 * jb + r32; const float gcj = VEC[j];
#pragma unroll
            for (int r = 0; r < 16; ++r) {
                const int i = 32 * ib + crow(r, hi); const float gci = VEC[i];
                if (which == 0) { const float v = (j < i) ? c[r] * VEC[128 + i] * __expf(gci - gcj) : 0.f; *(float*)(LB + DN_L + i * 256 + j * 4) = v; }
                else { const float v = (j <= i) ? c[r] * __expf(gci - gcj) : 0.f; *(bf16_t*)(LB + DN_IN + i * 144 + j * 2) = (bf16_t)(cvt_pk_bf16(v, 0.f) & 0xffffu); }
            }
        }
        __syncthreads();
        RELAUNDER();
        {
            float x[64];
            int oL = DN_L, oV = DN_VEC; asm volatile("" : "+v"(oL), "+v"(oV));
            const float* vecl = (const float*)(LB + oV);
            if (tid < 128) {
                int oS = DN_VW + 2 * tid; asm volatile("" : "+v"(oS));
#pragma unroll
                for (int i = 0; i < 64; ++i) { x[i] = vecl[128 + i] * bf2f(*(const bf16_t*)(LB + oS + i * 256)); if ((i & 7) == 7) __builtin_amdgcn_sched_barrier(0); }
            } else if (tid < 256) {
                int oS = DN_K + 2 * (tid - 128); asm volatile("" : "+v"(oS));
#pragma unroll
                for (int i = 0; i < 64; ++i) { x[i] = vecl[128 + i] * vecl[64 + i] * bf2f(*(const bf16_t*)(LB + oS + i * 272)); if ((i & 7) == 7) __builtin_amdgcn_sched_barrier(0); }
            }
            __syncthreads();
            if (tid < 256) {
#pragma unroll
                for (int sidx = 0; sidx < 16; ++sidx) {
                    const int j0 = 4 * sidx;
                    { const f32x4 l1 = *(const f32x4*)(lds + oL + (j0 + 1) * 256 + j0 * 4), l2 = *(const f32x4*)(lds + oL + (j0 + 2) * 256 + j0 * 4), l3 = *(const f32x4*)(lds + oL + (j0 + 3) * 256 + j0 * 4);
                      x[j0 + 1] -= l1[0] * x[j0];
                      x[j0 + 2] -= l2[0] * x[j0]; x[j0 + 2] -= l2[1] * x[j0 + 1];
                      x[j0 + 3] -= l3[0] * x[j0]; x[j0 + 3] -= l3[1] * x[j0 + 1]; x[j0 + 3] -= l3[2] * x[j0 + 2]; }
#pragma unroll
                    for (int i0 = j0 + 4; i0 < 64; i0 += 12) {
                        f32x4 lb[12];
#pragma unroll
                        for (int e = 0; e < 12; ++e) if (i0 + e < 64) lb[e] = *(const f32x4*)(lds + oL + (i0 + e) * 256 + j0 * 4);
                        __builtin_amdgcn_sched_barrier(0);
#pragma unroll
                        for (int e = 0; e < 12; ++e) if (i0 + e < 64) { const int i = i0 + e;
                            x[i] -= lb[e][0] * x[j0]; x[i] -= lb[e][1] * x[j0 + 1]; x[i] -= lb[e][2] * x[j0 + 2]; x[i] -= lb[e][3] * x[j0 + 3]; }
                        __builtin_amdgcn_sched_barrier(0);
                    }
                }
                if (tid < 128) {
                    int oD = DN_U + 2 * tid; asm volatile("" : "+v"(oD));
#pragma unroll
                    for (int i = 0; i < 64; ++i) *(bf16_t*)(LB + oD + i * 256) = (bf16_t)(cvt_pk_bf16(x[i], 0.f) & 0xffffu);
                } else {
                    int oD = DN_VW + 2 * (tid - 128); asm volatile("" : "+v"(oD));
#pragma unroll
                    for (int i = 0; i < 64; ++i) *(bf16_t*)(LB + oD + i * 272) = (bf16_t)(cvt_pk_bf16(x[i], 0.f) & 0xffffu);
                }
            }
        }
        __syncthreads();
        const int tb = wave >> 2, dvb = wave & 3;
        const int dvl = 32 * dvb + r32;
        RELAUNDER();
        {
            f32x16 c;
#pragma unroll
            for (int i = 0; i < 16; ++i) c[i] = 0.f;
            const unsigned char* ab = LB + DN_VW + (32 * tb + r32) * 272 + 16 * hi;
            const unsigned char* bb = LB + DN_ST + dvl * 272 + 16 * hi;
#pragma unroll
            for (int s = 0; s < 8; ++s) c = MFMA32(*(const bf16x8*)(ab + 32 * s), *(const bf16x8*)(bb + 32 * s), c);
#pragma unroll
            for (int r = 0; r < 16; ++r) c[r] = bf2f(*(const bf16_t*)(LB + DN_U + (32 * tb + crow(r, hi)) * 256 + 2 * dvl)) - c[r];
            __syncthreads();
#pragma unroll
            for (int g = 0; g < 4; ++g) { u32x2 w; w.x = cvt_pk_bf16(c[4 * g], c[4 * g + 1]); w.y = cvt_pk_bf16(c[4 * g + 2], c[4 * g + 3]);
                *(u32x2*)(LB + DN_VW + dvl * 144 + (32 * tb + 8 * g + 4 * hi) * 2) = w; }
        }
        __syncthreads();
        RELAUNDER();
        {
            f32x16 c;
#pragma unroll
            for (int i = 0; i < 16; ++i) c[i] = 0.f;
            const unsigned char* ab = LB + DN_Q + (32 * tb + r32) * 272 + 16 * hi;
            const unsigned char* bb = LB + DN_ST + dvl * 272 + 16 * hi;
#pragma unroll
            for (int s = 0; s < 8; ++s) c = MFMA32(*(const bf16x8*)(ab + 32 * s), *(const bf16x8*)(bb + 32 * s), c);
#pragma unroll
            for (int r = 0; r < 16; ++r) c[r] *= VEC[64 + 32 * tb + crow(r, hi)];
            const unsigned char* ib_ = LB + DN_IN + (32 * tb + r32) * 144 + 16 * hi;
            const unsigned char* vb_ = LB + DN_VW + dvl * 144 + 16 * hi;
#pragma unroll
            for (int s = 0; s < 4; ++s) c = MFMA32(*(const bf16x8*)(ib_ + 32 * s), *(const bf16x8*)(vb_ + 32 * s), c);
#pragma unroll
            for (int r = 0; r < 16; ++r) *(float*)(LB + DN_L + ((32 * tb + crow(r, hi)) * 128 + dvl) * 4) = c[r];
            const int dkb = wave >> 1, dv0 = (wave & 1) * 64;
            const float egl = __expf(gl);
            const unsigned char* ka = LB + DN_KT + (32 * dkb + r32) * 144 + 16 * hi;
            const unsigned char* v0 = LB + DN_VW + (dv0 + r32) * 144 + 16 * hi;
            const unsigned char* v1 = LB + DN_VW + (dv0 + 32 + r32) * 144 + 16 * hi;
#pragma unroll
            for (int i = 0; i < 16; ++i) { S0[i] *= egl; S1[i] *= egl; }
#pragma unroll
            for (int s = 0; s < 4; ++s) { const bf16x8 a = *(const bf16x8*)(ka + 32 * s); S0 = MFMA32(a, *(const bf16x8*)(v0 + 32 * s), S0); S1 = MFMA32(a, *(const bf16x8*)(v1 + 32 * s), S1); }
        }
        __syncthreads();
        {
        RELAUNDER();
            const int dkb = wave >> 1, dv0 = (wave & 1) * 64;
            asm volatile("s_nop 15\n\ts_nop 7" : "+v"(S0), "+v"(S1));
#pragma unroll
            for (int g = 0; g < 4; ++g) {
                u32x2 w; w.x = cvt_pk_bf16(S0[4 * g], S0[4 * g + 1]); w.y = cvt_pk_bf16(S0[4 * g + 2], S0[4 * g + 3]);
                *(u32x2*)(LB + DN_ST + (dv0 + r32) * 272 + (32 * dkb + 8 * g + 4 * hi) * 2) = w;
                w.x = cvt_pk_bf16(S1[4 * g], S1[4 * g + 1]); w.y = cvt_pk_bf16(S1[4 * g + 2], S1[4 * g + 3]);
                *(u32x2*)(LB + DN_ST + (dv0 + 32 + r32) * 272 + (32 * dkb + 8 * g + 4 * hi) * 2) = w;
            }
#pragma unroll
            for (int i = 0; i < 8; ++i) {
                const int t = wave * 8 + i;
                const float o0 = *(const float*)(LB + DN_L + (t * 128 + 2 * lane) * 4), o1 = *(const float*)(LB + DN_L + (t * 128 + 2 * lane + 1) * 4);
                const float ssq = wave_sum(o0 * o0 + o1 * o1);
                const float rs = rsqrtf(ssq * (1.0f / 128.0f) + 1e-6f);
                const unsigned zu = zq[i];
                unsigned* zp = (unsigned*)(proj + (rowc + t) * NPJ + 3072 + h * 128 + 2 * lane);
                unsigned* zo = dry ? (unsigned*)((bf16_t*)(p.ws + WS_XB) + (rowc + t) * 1024 + 512 + h * 128 + 2 * lane) : zp;
                *zo = cvt_pk_bf16(o0 * rs * gn0 * silu_f(bflo(zu)), o1 * rs * gn1 * silu_f(bfhi(zu)));
            }
        }
    }
#undef RELAUNDER
    {
        float* so = p.out + O_PBS + ((size_t)(b * 4 + h)) * 16384;
        const int dkb = wave >> 1, dv0 = (wave & 1) * 64;
#pragma unroll
        for (int r = 0; r < 16; ++r) { const int dk = 32 * dkb + crow(r, hi); so[dk * 128 + dv0 + r32] = S0[r]; so[dk * 128 + dv0 + 32 + r32] = S1[r]; }
    }
    __syncthreads();
}

DI void dn_sample(const Prm& p, unsigned char* lds, int tid, int wave, int lane, int b, int h, bool dry) {
    bf16_t* proj = (bf16_t*)(p.ws + WS_BIG); const float* bd = (const float*)(p.ws + WS_BD);
    float* qkv = (float*)lds;
    float* red = (float*)(lds + 24576);
    float* ost = (float*)(lds + 24576 + 4096);
    const size_t row0 = (size_t)MP + b * 16;
    for (int idx = tid; idx < 6144; idx += NT) {
        const int t = idx / 384, ch = idx % 384, pt = ch >> 7, cc = ch & 127, pc = pt * 512 + h * 128 + cc;
        float a = 0.f;
#pragma unroll
        for (int j = 0; j < 4; ++j) { const int m = t + j;
            const float xv = m < 3 ? p.in[4][((size_t)b * 3 + m) * 1536 + pc] : bf2f(proj[(row0 + m - 3) * NPJ + 1536 + pc]);
            a += xv * p.in[16][(size_t)j * 1536 + pc]; }
        qkv[(pt * 16 + t) * 128 + cc] = silu_f(a);
    }
    __syncthreads();
    for (int rr = wave; rr < 32; rr += 8) {
        float* r = qkv + rr * 128; const float a = r[2 * lane], c = r[2 * lane + 1];
        const float s = wave_sum(a * a + c * c); const float sc = rsqrtf(s + 1e-6f) * (rr < 16 ? 0.08838834764831845f : 1.0f);
        r[2 * lane] = a * sc; r[2 * lane + 1] = c * sc;
    }
    __syncthreads();
    const int c = tid & 127, qd = tid >> 7;
    float S[32];
    const float* s0 = p.in[5] + ((size_t)(b * 4 + h)) * 16384;
#pragma unroll
    for (int i = 0; i < 32; ++i) S[i] = s0[(qd * 32 + i) * 128 + c];
    for (int t = 0; t < 16; ++t) {
        const float* qv = qkv + t * 128 + qd * 32; const float* kv = qkv + (16 + t) * 128 + qd * 32; const float vv = qkv[(32 + t) * 128 + c];
        const float be = bd[(row0 + t) * 8 + h], a = __expf(bd[(row0 + t) * 8 + 4 + h]);
        float pk = 0.f;
#pragma unroll
        for (int i = 0; i < 32; ++i) pk += kv[i] * S[i];
        red[qd * 128 + c] = pk;
        __syncthreads();
        const float ks = (red[c] + red[128 + c]) + (red[256 + c] + red[384 + c]);
        const float coef = be * (vv - a * ks);
        float po = 0.f;
#pragma unroll
        for (int i = 0; i < 32; ++i) { S[i] = a * S[i] + kv[i] * coef; po += qv[i] * S[i]; }
        red[512 + qd * 128 + c] = po;
        __syncthreads();
        if (qd == 0) ost[t * 128 + c] = (red[512 + c] + red[640 + c]) + (red[768 + c] + red[896 + c]);
    }
    float* so = p.out + O_SBS + ((size_t)(b * 4 + h)) * 16384;
#pragma unroll
    for (int i = 0; i < 32; ++i) so[(qd * 32 + i) * 128 + c] = S[i];
    __syncthreads();
    for (int t = wave; t < 16; t += 8) {
        const float o0 = ost[t * 128 + 2 * lane], o1 = ost[t * 128 + 2 * lane + 1];
        const float rs = rsqrtf(wave_sum(o0 * o0 + o1 * o1) * (1.0f / 128.0f) + 1e-6f);
        unsigned* zp = (unsigned*)(proj + (row0 + t) * NPJ + 3072 + h * 128 + 2 * lane);
        const unsigned zu = *zp;
        unsigned* zo = dry ? (unsigned*)((bf16_t*)(p.ws + WS_XB) + (row0 + t) * 1024 + 512 + h * 128 + 2 * lane) : zp;
        *zo = cvt_pk_bf16(o0 * rs * p.in[19][2 * lane] * silu_f(bflo(zu)), o1 * rs * p.in[19][2 * lane + 1] * silu_f(bfhi(zu)));
    }
    __syncthreads();
}

constexpr int AT_BIAS = 131072;
constexpr float LOG2E = 1.4426950408889634f;
DI void attn_unit(const Prm& p, unsigned char* lds, int wave, int lane, int u, bool dry) {
    bf16_t* proj = (bf16_t*)(p.ws + WS_BIG);
    const int r32 = lane & 31, hi = lane >> 5;
    const int half = u & 1, h = (u >> 1) & 7, c = (u >> 4) & 31, b = u >> 9;
    unsigned char* vt = lds + wave * 16384;
    const float* bias = (const float*)(lds + AT_BIAS) + h * 257;
    const size_t qrow = (size_t)b * 2048 + c * 64 + half * 32 + r32;
    bf16x8 qf[4];
#pragma unroll
    for (int d0 = 0; d0 < 4; ++d0) qf[d0] = *(const bf16x8*)(proj + qrow * NPJ + h * 64 + 16 * d0 + 8 * hi);
    f32x16 o0, o1;
#pragma unroll
    for (int i = 0; i < 16; ++i) { o0[i] = 0.f; o1[i] = 0.f; }
    float mrun = -1e30f, lrun = 0.f;
    const float cbias = bias[256];
    const int qpos = half * 32 + r32;
    const float sc = 0.125f * LOG2E;
    const int jfirst = (c < 8 ? 8 - c : 0);
    bf16x8 kf[8];
    { const bf16_t* kp0 = proj + ((size_t)b * 2048 + (size_t)(c - 8 + jfirst) * 64 + r32) * NPJ + 512 + h * 64 + 8 * hi;
#pragma unroll
      for (int d0 = 0; d0 < 4; ++d0) { kf[2 * d0] = *(const bf16x8*)(kp0 + 16 * d0); kf[2 * d0 + 1] = *(const bf16x8*)(kp0 + (size_t)32 * NPJ + 16 * d0); } }
    for (int j = jfirst; j < 9; ++j) {
        const size_t krow0 = (size_t)b * 2048 + (size_t)(c - 8 + j) * 64;
        u32x4 va[4], vb[4];
#pragma unroll
        for (int i = 0; i < 4; ++i) { const int pair = lane & 31, ch = (lane >> 5) + 2 * i;
            const bf16_t* vp = proj + (krow0 + 2 * pair) * NPJ + 1024 + h * 64 + 8 * ch;
            va[i] = *(const u32x4*)vp; vb[i] = *(const u32x4*)(vp + NPJ); }
        f32x16 p0, p1;
#pragma unroll
        for (int i = 0; i < 16; ++i) { p0[i] = 0.f; p1[i] = 0.f; }
        bf16x8 kn[8];
        if (j + 1 < 9) { const bf16_t* kpn = proj + (krow0 + 64 + r32) * NPJ + 512 + h * 64 + 8 * hi;
#pragma unroll
            for (int d0 = 0; d0 < 4; ++d0) { kn[2 * d0] = *(const bf16x8*)(kpn + 16 * d0); kn[2 * d0 + 1] = *(const bf16x8*)(kpn + (size_t)32 * NPJ + 16 * d0); } }
        else {
#pragma unroll
            for (int d0 = 0; d0 < 8; ++d0) kn[d0] = kf[d0]; }
#pragma unroll
        for (int d0 = 0; d0 < 4; ++d0) { p0 = MFMA32(kf[2 * d0], qf[d0], p0); p1 = MFMA32(kf[2 * d0 + 1], qf[d0], p1); }
        if (j <= 5) {
#pragma unroll
            for (int r = 0; r < 16; ++r) { p0[r] = p0[r] * sc + cbias; p1[r] = p1[r] * sc + cbias; }
        } else {
            const int kb0 = (j - 8) * 64;
#pragma unroll
            for (int r = 0; r < 16; ++r) {
                int d = qpos - (kb0 + crow(r, hi)); int d1 = d - 32;
                d = d < -128 ? -128 : (d > 128 ? 128 : d); d1 = d1 < -128 ? -128 : (d1 > 128 ? 128 : d1);
                p0[r] = p0[r] * sc + bias[d + 128]; p1[r] = p1[r] * sc + bias[d1 + 128];
            }
        }
        float mt = p0[0];
#pragma unroll
        for (int r = 0; r < 16; ++r) { mt = fmaxf(mt, p0[r]); mt = fmaxf(mt, p1[r]); }
        mt = fmaxf(mt, __shfl_xor(mt, 32));
        const float mn = fmaxf(mrun, mt), alpha = exp2f(mrun - mn);
        mrun = mn;
        float ls = 0.f;
#pragma unroll
        for (int r = 0; r < 16; ++r) { p0[r] = exp2f(p0[r] - mn); p1[r] = exp2f(p1[r] - mn); ls += p0[r] + p1[r]; }
        lrun = lrun * alpha + ls;
#pragma unroll
        for (int r = 0; r < 16; ++r) { o0[r] *= alpha; o1[r] *= alpha; }
#pragma unroll
        for (int i = 0; i < 4; ++i) { const int pair = lane & 31, ch = (lane >> 5) + 2 * i; const int key = 2 * pair, pos = 16 * (key >> 4) + kslot(key & 15);
            unsigned char* wp = vt + (8 * ch) * 144 + pos * 2;
            const unsigned a0 = va[i].x, a1 = va[i].y, a2 = va[i].z, a3 = va[i].w, b0 = vb[i].x, b1 = vb[i].y, b2 = vb[i].z, b3 = vb[i].w;
            *(unsigned*)(wp + 0 * 144) = (a0 & 0xffffu) | (b0 << 16); *(unsigned*)(wp + 1 * 144) = (a0 >> 16) | (b0 & 0xffff0000u);
            *(unsigned*)(wp + 2 * 144) = (a1 & 0xffffu) | (b1 << 16); *(unsigned*)(wp + 3 * 144) = (a1 >> 16) | (b1 & 0xffff0000u);
            *(unsigned*)(wp + 4 * 144) = (a2 & 0xffffu) | (b2 << 16); *(unsigned*)(wp + 5 * 144) = (a2 >> 16) | (b2 & 0xffff0000u);
            *(unsigned*)(wp + 6 * 144) = (a3 & 0xffffu) | (b3 << 16); *(unsigned*)(wp + 7 * 144) = (a3 >> 16) | (b3 & 0xffff0000u); }
        __builtin_amdgcn_wave_barrier(); asm volatile("s_waitcnt lgkmcnt(0)" ::: "memory");
        const unsigned char* vr = vt + r32 * 144 + 16 * hi;
#pragma unroll
        for (int kb4 = 0; kb4 < 4; ++kb4) {
            const bf16x8 pf = (kb4 < 2) ? pack8(p0, kb4 & 1) : pack8(p1, kb4 & 1);
            o0 = MFMA32(*(const bf16x8*)(vr + 32 * kb4), pf, o0);
            o1 = MFMA32(*(const bf16x8*)(vr + 32 * 144 + 32 * kb4), pf, o1);
        }
        __builtin_amdgcn_wave_barrier(); asm volatile("s_waitcnt lgkmcnt(0)" ::: "memory");
#pragma unroll
        for (int d0 = 0; d0 < 8; ++d0) kf[d0] = kn[d0];
    }
    lrun += __shfl_xor(lrun, 32);
    const float inv = 1.0f / lrun;
    bf16_t* op = dry ? (bf16_t*)(p.ws + WS_XB) + qrow * 1024 + h * 64 : proj + qrow * NPJ + h * 64;
#pragma unroll
    for (int g = 0; g < 4; ++g) {
        u32x2 w; w.x = cvt_pk_bf16(o0[4 * g] * inv, o0[4 * g + 1] * inv); w.y = cvt_pk_bf16(o0[4 * g + 2] * inv, o0[4 * g + 3] * inv);
        *(u32x2*)(op + 8 * g + 4 * hi) = w;
        w.x = cvt_pk_bf16(o1[4 * g] * inv, o1[4 * g + 1] * inv); w.y = cvt_pk_bf16(o1[4 * g + 2] * inv, o1[4 * g + 3] * inv);
        *(u32x2*)(op + 32 + 8 * g + 4 * hi) = w;
    }
}

DI void attn_sample(const Prm& p, unsigned char* lds, int tid, int wave, int lane, int b, int h, bool dry) {
    bf16_t* proj = (bf16_t*)(p.ws + WS_BIG);
    float* qs = (float*)lds;
    float* S = (float*)(lds + 4096);
    const float* biasg = p.in[15] + h * 257;
    const size_t row0 = (size_t)MP + b * 16;
    __syncthreads();
    for (int idx = tid; idx < 1024; idx += NT) { const int t = idx >> 6, d = idx & 63; qs[idx] = bf2f(proj[(row0 + t) * NPJ + h * 64 + d]); }
    __syncthreads();
    for (int kk = tid; kk < 528; kk += NT) {
        float kr[64];
        if (kk < 512) { const f32x4* kp = (const f32x4*)(p.in[2] + (((size_t)b * 512 + kk) * 8 + h) * 64);
#pragma unroll
            for (int i = 0; i < 16; ++i) { const f32x4 v = kp[i]; kr[4 * i] = v[0]; kr[4 * i + 1] = v[1]; kr[4 * i + 2] = v[2]; kr[4 * i + 3] = v[3]; } }
        else { const bf16_t* kp = proj + (row0 + kk - 512) * NPJ + 512 + h * 64;
#pragma unroll
            for (int i = 0; i < 64; ++i) kr[i] = bf2f(kp[i]); }
        const int kpos = kk - 512;
        for (int t = 0; t < 16; ++t) {
            float a = 0.f;
#pragma unroll
            for (int i = 0; i < 64; ++i) a += qs[t * 64 + i] * kr[i];
            int d = t - kpos; d = d < -128 ? -128 : (d > 128 ? 128 : d);
            S[t * 528 + kk] = a * 0.125f + biasg[d + 128];
        }
    }
    __syncthreads();
    for (int t = wave; t < 16; t += 8) {
        float m = -1e30f;
        for (int kk = lane; kk < 528; kk += 64) m = fmaxf(m, S[t * 528 + kk]);
#pragma unroll
        for (int o = 1; o < 64; o <<= 1) m = fmaxf(m, __shfl_xor(m, o));
        float s = 0.f;
        for (int kk = lane; kk < 528; kk += 64) { const float e = __expf(S[t * 528 + kk] - m); S[t * 528 + kk] = e; s += e; }
        s = wave_sum(s); const float inv = 1.0f / s;
        for (int kk = lane; kk < 528; kk += 64) S[t * 528 + kk] *= inv;
    }
    __syncthreads();
    {
        const int d = tid & 63, t0 = (tid >> 6) * 2;
        float a0 = 0.f, a1 = 0.f;
        for (int kk = 0; kk < 528; ++kk) {
            const float v = kk < 512 ? p.in[3][(((size_t)b * 512 + kk) * 8 + h) * 64 + d] : bf2f(proj[(row0 + kk - 512) * NPJ + 1024 + h * 64 + d]);
            a0 += S[t0 * 528 + kk] * v; a1 += S[(t0 + 1) * 528 + kk] * v;
        }
        bf16_t* ob_ = dry ? (bf16_t*)(p.ws + WS_XB) + (row0 + t0) * 1024 + h * 64 + d : proj + (row0 + t0) * NPJ + h * 64 + d;
        ob_[0] = (bf16_t)(cvt_pk_bf16(a0, 0.f) & 0xffffu);
        ob_[dry ? 1024 : NPJ] = (bf16_t)(cvt_pk_bf16(a1, 0.f) & 0xffffu);
    }
    __syncthreads();
}

DI void xattn_stage_v(const bf16_t* memv, unsigned char* lds, int tid, size_t kvrow0, int h) {
    __syncthreads();
#pragma unroll 2
    for (int i = 0; i < 8; ++i) { const int item = tid + NT * i, pair = item & 127, ch = item >> 7;
        const bf16_t* vp = memv + (kvrow0 + 2 * pair) * DM + h * 256 + 8 * ch;
        const u32x4 a = *(const u32x4*)vp, bq = *(const u32x4*)(vp + DM);
        const int key = 2 * pair, pos = 16 * (key >> 4) + kslot(key & 15);
        unsigned char* wp = lds + (8 * ch) * 528 + pos * 2;
        *(unsigned*)(wp + 0 * 528) = (a.x & 0xffffu) | (bq.x << 16); *(unsigned*)(wp + 1 * 528) = (a.x >> 16) | (bq.x & 0xffff0000u);
        *(unsigned*)(wp + 2 * 528) = (a.y & 0xffffu) | (bq.y << 16); *(unsigned*)(wp + 3 * 528) = (a.y >> 16) | (bq.y & 0xffff0000u);
        *(unsigned*)(wp + 4 * 528) = (a.z & 0xffffu) | (bq.z << 16); *(unsigned*)(wp + 5 * 528) = (a.z >> 16) | (bq.z & 0xffff0000u);
        *(unsigned*)(wp + 6 * 528) = (a.w & 0xffffu) | (bq.w << 16); *(unsigned*)(wp + 7 * 528) = (a.w >> 16) | (bq.w & 0xffff0000u); }
    __syncthreads();
}
constexpr int XK_OFF = 135168;
#define XBAR() do { asm volatile("s_waitcnt lgkmcnt(0)" ::: "memory"); __builtin_amdgcn_s_barrier(); asm volatile("" ::: "memory"); } while (0)
DI void xattn_unit_k(const bf16_t* qx, const bf16_t* memk, bf16_t* ox, unsigned char* lds, int tid, int lane, size_t qrow0, size_t kvrow0, int h, int nvalid, int dh) {
    const int r32 = lane & 31, hi = lane >> 5;
    f32x16 o[4];
#pragma unroll
    for (int d = 0; d < 4; ++d)
#pragma unroll
        for (int i = 0; i < 16; ++i) o[d][i] = 0.f;
    float mrun = -1e30f, lrun = 0.f;
    const bf16_t* qp = qx + (qrow0 + r32) * DM + h * 256 + 8 * hi;
    const int kkey = tid >> 5, kc16 = tid & 31;
    const bf16_t* kg = memk + (kvrow0 + kkey) * DM + h * 256 + 8 * kc16;
    unsigned char* kl = lds + XK_OFF + kkey * 528 + kc16 * 16;
    u32x4 kr0 = *(const u32x4*)kg, kr1 = *(const u32x4*)(kg + (size_t)16 * DM);
    bf16x8 qf[16];
#pragma unroll
    for (int s = 0; s < 16; ++s) qf[s] = *(const bf16x8*)(qp + 16 * s);
    for (int kt = 0; kt < 4; ++kt) {
        f32x16 p0, p1;
#pragma unroll
        for (int i = 0; i < 16; ++i) { p0[i] = 0.f; p1[i] = 0.f; }
#pragma unroll
        for (int hf = 0; hf < 2; ++hf) {
            XBAR();
            *(u32x4*)kl = kr0; *(u32x4*)(kl + 16 * 528) = kr1;
            { const int nh = 2 * kt + hf + 1;
              if (nh < 8) { const bf16_t* g2 = kg + (size_t)(32 * nh) * DM; kr0 = *(const u32x4*)g2; kr1 = *(const u32x4*)(g2 + (size_t)16 * DM); } }
            XBAR();
            const unsigned char* kb = lds + XK_OFF + r32 * 528 + 16 * hi;
            if (hf == 0) {
#pragma unroll
                for (int sb = 0; sb < 2; ++sb) { bf16x8 kfr[8];
#pragma unroll
                    for (int s = 0; s < 8; ++s) kfr[s] = *(const bf16x8*)(kb + 32 * (8 * sb + s));
                    __builtin_amdgcn_sched_barrier(0);
#pragma unroll
                    for (int s = 0; s < 8; ++s) p0 = MFMA32(kfr[s], qf[8 * sb + s], p0);
                    __builtin_amdgcn_sched_barrier(0); }
            } else {
#pragma unroll
                for (int sb = 0; sb < 2; ++sb) { bf16x8 kfr[8];
#pragma unroll
                    for (int s = 0; s < 8; ++s) kfr[s] = *(const bf16x8*)(kb + 32 * (8 * sb + s));
                    __builtin_amdgcn_sched_barrier(0);
#pragma unroll
                    for (int s = 0; s < 8; ++s) p1 = MFMA32(kfr[s], qf[8 * sb + s], p1);
                    __builtin_amdgcn_sched_barrier(0); }
            }
        }
        float mt = p0[0];
#pragma unroll
        for (int r = 0; r < 16; ++r) { mt = fmaxf(mt, p0[r]); mt = fmaxf(mt, p1[r]); }
        mt = fmaxf(mt, __shfl_xor(mt, 32));
        const float mn = fmaxf(mrun, mt), alpha = exp2f(mrun - mn);
        mrun = mn;
        float ls = 0.f;
#pragma unroll
        for (int r = 0; r < 16; ++r) { p0[r] = exp2f(p0[r] - mn); p1[r] = exp2f(p1[r] - mn); ls += p0[r] + p1[r]; }
        lrun = lrun * alpha + ls;
#pragma unroll
        for (int d = 0; d < 4; ++d)
#pragma unroll
            for (int r = 0; r < 16; ++r) o[d][r] *= alpha;
        const unsigned char* vr = lds + (128 * dh + r32) * 528 + (64 * kt + 8 * hi) * 2;
#pragma unroll
        for (int kb4 = 0; kb4 < 4; ++kb4) {
            const bf16x8 pf = (kb4 < 2) ? pack8(p0, kb4 & 1) : pack8(p1, kb4 & 1); bf16x8 vfr[4];
#pragma unroll
            for (int d = 0; d < 4; ++d) vfr[d] = *(const bf16x8*)(vr + d * 32 * 528 + 32 * kb4);
            __builtin_amdgcn_sched_barrier(0);
#pragma unroll
            for (int d = 0; d < 4; ++d) o[d] = MFMA32(vfr[d], pf, o[d]);
        }
    }
    lrun += __shfl_xor(lrun, 32);
    const float inv = 1.0f / lrun;
    if (r32 < nvalid) {
        bf16_t* op = ox + (qrow0 + r32) * DM + h * 256 + 128 * dh;
#pragma unroll
        for (int d = 0; d < 4; ++d)
#pragma unroll
            for (int g = 0; g < 4; ++g) {
                u32x2 w; w.x = cvt_pk_bf16(o[d][4 * g] * inv, o[d][4 * g + 1] * inv); w.y = cvt_pk_bf16(o[d][4 * g + 2] * inv, o[d][4 * g + 3] * inv);
                *(u32x2*)(op + 32 * d + 8 * g + 4 * hi) = w;
            }
    }
    XBAR();
}
DI void xattn_wave(const bf16_t* qx, const bf16_t* memk, bf16_t* ox, const unsigned char* lds, int lane, size_t qrow0, size_t kvrow0, int h, int nvalid) {
    const int r32 = lane & 31, hi = lane >> 5;
    f32x16 o[8];
#pragma unroll
    for (int d = 0; d < 8; ++d)
#pragma unroll
        for (int i = 0; i < 16; ++i) o[d][i] = 0.f;
    float mrun = -1e30f, lrun = 0.f;
    const bf16_t* qp = qx + (qrow0 + r32) * DM + h * 256 + 8 * hi;
    for (int kt = 0; kt < 4; ++kt) {
        f32x16 p0, p1;
#pragma unroll
        for (int i = 0; i < 16; ++i) { p0[i] = 0.f; p1[i] = 0.f; }
        const bf16_t* kp = memk + (kvrow0 + 64 * kt + r32) * DM + h * 256 + 8 * hi;
#pragma unroll 4
        for (int s = 0; s < 16; ++s) { const bf16x8 q = *(const bf16x8*)(qp + 16 * s), k0 = *(const bf16x8*)(kp + 16 * s), k1 = *(const bf16x8*)(kp + (size_t)32 * DM + 16 * s);
            p0 = MFMA32(k0, q, p0); p1 = MFMA32(k1, q, p1); }
        float mt = p0[0];
#pragma unroll
        for (int r = 0; r < 16; ++r) { mt = fmaxf(mt, p0[r]); mt = fmaxf(mt, p1[r]); }
        mt = fmaxf(mt, __shfl_xor(mt, 32));
        const float mn = fmaxf(mrun, mt), alpha = exp2f(mrun - mn);
        mrun = mn;
        float ls = 0.f;
#pragma unroll
        for (int r = 0; r < 16; ++r) { p0[r] = exp2f(p0[r] - mn); p1[r] = exp2f(p1[r] - mn); ls += p0[r] + p1[r]; }
        lrun = lrun * alpha + ls;
#pragma unroll
        for (int d = 0; d < 8; ++d)
#pragma unroll
            for (int r = 0; r < 16; ++r) o[d][r] *= alpha;
        const unsigned char* vr = lds + r32 * 528 + (64 * kt + 8 * hi) * 2;
#pragma unroll
        for (int kb4 = 0; kb4 < 4; ++kb4) {
            const bf16x8 pf = (kb4 < 2) ? pack8(p0, kb4 & 1) : pack8(p1, kb4 & 1);
#pragma unroll
            for (int d = 0; d < 8; ++d) o[d] = MFMA32(*(const bf16x8*)(vr + d * 32 * 528 + 32 * kb4), pf, o[d]);
        }
    }
    lrun += __shfl_xor(lrun, 32);
    const float inv = 1.0f / lrun;
    if (r32 < nvalid) {
        bf16_t* op = ox + (qrow0 + r32) * DM + h * 256;
#pragma unroll
        for (int d = 0; d < 8; ++d)
#pragma unroll
            for (int g = 0; g < 4; ++g) {
                u32x2 w; w.x = cvt_pk_bf16(o[d][4 * g] * inv, o[d][4 * g + 1] * inv); w.y = cvt_pk_bf16(o[d][4 * g + 2] * inv, o[d][4 * g + 3] * inv);
                *(u32x2*)(op + 32 * d + 8 * g + 4 * hi) = w;
            }
    }
}

#define LAS __attribute__((address_space(3)))
#define XB_TMO      128
#define XB_XCNT(j)  (256  + 64 * (j))
#define XB_XSUB(j)  (1280 + 64 * (j))
#define XB_XGEN(j)  (2304 + 64 * (j))
#define XB_TOP      3328
#define XB_TOPGEN   3392
#define XCD_BAR_WORDS 3456
#define XB_SPIN_CAP (1u << 18)

__device__ __forceinline__ unsigned xb_ld(unsigned* p)              { return __hip_atomic_load(p, __ATOMIC_RELAXED, __HIP_MEMORY_SCOPE_AGENT); }
__device__ __forceinline__ unsigned xb_add(unsigned* p, unsigned v) { return __hip_atomic_fetch_add(p, v, __ATOMIC_RELAXED, __HIP_MEMORY_SCOPE_AGENT); }
__device__ __forceinline__ unsigned xb_xcc_id() { return (unsigned)__builtin_amdgcn_s_getreg((3 << 11) | 20) & 0xFu; }
#define XB_SPIN(cond, bar) do { unsigned _sp = 0; while (cond) { __builtin_amdgcn_s_sleep(1); \
    if ((++_sp & 255u) == 0u) { if (xb_ld(&(bar)[XB_TMO])) break; if (_sp > XB_SPIN_CAP) { atomicAdd(&(bar)[XB_TMO], 1u); break; } } } } while (0)

struct XcdBarrier {
    unsigned* bar; unsigned x;
    volatile LAS unsigned* st;
};

__device__ __forceinline__ XcdBarrier xcd_barrier_post(unsigned* bar, volatile LAS unsigned* st) {
    XcdBarrier b; b.bar = bar; b.x = xb_xcc_id(); b.st = st;
    if (threadIdx.x == 0) (void)xb_add(&bar[XB_XCNT(b.x)], 1u);
    return b;
}
__device__ __forceinline__ void xcd_barrier_complete(unsigned* bar, unsigned x, unsigned& nloc, unsigned& nx) {
    const unsigned G = gridDim.x * gridDim.y * gridDim.z;
    unsigned sum, cnt, mine, sp = 0u;
    for (;;) {
        sum = 0u; cnt = 0u; mine = 0u;
#pragma unroll
        for (unsigned j = 0; j < 16; ++j) { const unsigned c = xb_ld(&bar[XB_XCNT(j)]); sum += c; cnt += (c > 0u) ? 1u : 0u; mine = (j == x) ? c : mine; }
        if (sum == G) break;
        __builtin_amdgcn_s_sleep(1);
        if ((++sp & 255u) == 0u) { if (xb_ld(&bar[XB_TMO])) break; if (sp > XB_SPIN_CAP) { atomicAdd(&bar[XB_TMO], 1u); break; } }
    }
    nloc = mine > 0u ? mine : 1u; nx = cnt > 0u ? cnt : 1u;
}

__device__ __forceinline__ void xcd_barrier(const XcdBarrier& b) {
    asm volatile("s_waitcnt vmcnt(0)" ::: "memory");
    __syncthreads();
    if (threadIdx.x == 0) {
        unsigned* bar = b.bar;
        __builtin_amdgcn_s_waitcnt(0);
        unsigned nloc = b.st[0], nx = b.st[1];
        if (nloc == 0u) { xcd_barrier_complete(bar, b.x, nloc, nx); b.st[0] = nloc; b.st[1] = nx; }
        const unsigned old = xb_add(&bar[XB_XSUB(b.x)], 1u);
        const unsigned gen = old / nloc;
        if (old + 1u == (gen + 1u) * nloc) {
            __builtin_amdgcn_fence(__ATOMIC_RELEASE, "agent");
            asm volatile("s_waitcnt vmcnt(0)" ::: "memory");
            const unsigned og = xb_add(&bar[XB_TOP], 1u);
            const unsigned tg = og / nx;
            if (og + 1u == (tg + 1u) * nx) xb_add(&bar[XB_TOPGEN], 1u);
            else XB_SPIN(xb_ld(&bar[XB_TOPGEN]) == tg, bar);
            __builtin_amdgcn_fence(__ATOMIC_ACQUIRE, "agent");
            xb_add(&bar[XB_XGEN(b.x)], 1u);
            asm volatile("s_waitcnt vmcnt(0)" ::: "memory");
        } else {
            XB_SPIN(xb_ld(&bar[XB_XGEN(b.x)]) == gen, bar);
            __builtin_amdgcn_fence(__ATOMIC_ACQUIRE, "agent");
            asm volatile("s_waitcnt vmcnt(0)" ::: "memory");
        }
    }
    __syncthreads();
}

#ifndef SUB
#define SUB 0xffu
#endif
#ifndef DRYSUB
#define DRYSUB 0xffu
#endif
#ifndef PROBE
#define PROBE 0
#endif
#ifndef PHMASK
#define PHMASK 0xffffu
#endif
__global__ void __launch_bounds__(NT, 2) hybrid_fwd(Prm p) {
    extern __shared__ __attribute__((aligned(16))) unsigned char lds[];
    cg::grid_group grid = cg::this_grid();
    int tid = threadIdx.x, lane = tid & 63, wave = __builtin_amdgcn_readfirstlane(tid >> 6);
    const int G = gridDim.x, wg = blockIdx.x, NGW = G * 8; int gw = wg * 8 + wave;
#define RELAUNDER_IDS() do { tid = threadIdx.x; asm volatile("" : "+v"(tid)); lane = tid & 63; wave = __builtin_amdgcn_readfirstlane(tid >> 6); gw = wg * 8 + wave; } while (0)
    unsigned char* ws = p.ws;
    __attribute__((address_space(3))) unsigned char* lds3 = (__attribute__((address_space(3))) unsigned char*)lds;
    bf16_t* xb = (bf16_t*)(ws + WS_XB); bf16_t* big = (bf16_t*)(ws + WS_BIG);
    float* ss0 = (float*)(ws + WS_SS); float* ss1 = (float*)(ws + WS_SS + SS_STRIDE); float* ss2 = (float*)(ws + WS_SS + 2 * SS_STRIDE);
    float* ss3 = (float*)(ws + WS_SS + 3 * SS_STRIDE); float* ss4 = (float*)(ws + WS_SS + 4 * SS_STRIDE);
    float* xo = p.out;
    unsigned* ctl = (unsigned*)(ws + WS_CTL);
    volatile LAS unsigned* xst = (volatile LAS unsigned*)(lds3 + 163824);
    if (tid == 0) { xst[0] = 0u; xst[1] = 0u; }
    __syncthreads();
    XcdBarrier xbar = xcd_barrier_post(ctl + 4096, xst);

    if (PHMASK & (1u << 0))
    phase0(p, lds, wave, lane, gw, NGW);
    asm volatile("s_waitcnt vmcnt(0) lgkmcnt(0)" ::: "memory"); __syncthreads();
    grid.sync();
    RELAUNDER_IDS();
    if (PHMASK & (1u << 1))
    for (int rep1 = (PROBE & 2) ? 0 : 1; rep1 < 2; ++rep1)
    {
        pg8::Gemm g{xb, (const bf16_t*)(ws + WS_WGU1), MT, 2 * DFF, DM, DM}; pg8::StaticOrder S; S.init(MT, 2 * DFF, G, wg);
        pg8::EpiSwiglu E{big, DFF, ss0};
        pg8::gemm_phase<pg8::EpiSwiglu, pg8::StaticOrder, true, true>(lds3, g, S, E);
    }
    asm volatile("s_waitcnt vmcnt(0) lgkmcnt(0)" ::: "memory"); __syncthreads();
    xcd_barrier(xbar);
    RELAUNDER_IDS();
    if (PHMASK & (1u << 2))
    {
        pg8::Gemm g{big, (const bf16_t*)(ws + WS_WD1), MT, DM, DFF, DFF}; pg8::StaticOrder S; S.init(MT, DM, G, wg);
        pg8::EpiRes E{p.in[0], p.in[1], xo, xb, ss1, 0.5f};
        pg8::gemm_phase<pg8::EpiRes, pg8::StaticOrder, true, true>(lds3, g, S, E);
        if (wg >= 4) {
            pg8::Gemm g2{(const bf16_t*)(ws + WS_MEMB), (const bf16_t*)(ws + WS_WKV), 8192, 2048, DM, DM}; pg8::StaticOrder S2; S2.init(8192, 2048, G - 4, wg - 4);
            pg8::EpiMemKV E2{p.out + O_PMK, p.out + O_PMV, (bf16_t*)(ws + WS_MEMK), (bf16_t*)(ws + WS_MEMV), (const float*)(ws + WS_SSM)};
            pg8::gemm_phase<pg8::EpiMemKV, pg8::StaticOrder, true, true>(lds3, g2, S2, E2);
        }
    }
    asm volatile("s_waitcnt vmcnt(0) lgkmcnt(0)" ::: "memory"); __syncthreads();
    xcd_barrier(xbar);
    RELAUNDER_IDS();
    if (PHMASK & (1u << 3))
    {
        pg8::Gemm g{xb, (const bf16_t*)(ws + WS_WIN), MT, NPJ, DM, DM}; pg8::StaticOrder S; S.init(MT, NPJ, G, wg);
        pg8::EpiScale E{big, NPJ, ss1, 1.0f};
        pg8::gemm_phase<pg8::EpiScale, pg8::StaticOrder, true, true>(lds3, g, S, E);
        if (SUB & 32) bd_pass(p, lds, tid, wave, lane, gw, NGW);
    }
    asm volatile("s_waitcnt vmcnt(0) lgkmcnt(0)" ::: "memory"); __syncthreads();
    xcd_barrier(xbar);
    RELAUNDER_IDS();
    if (PHMASK & (1u << 4))
    for (int rep = (PROBE & 1) ? 0 : 1; rep < 2; ++rep)
    {
        const bool dry = (rep == 0);
        RELAUNDER_IDS();
        const unsigned SUBM = dry ? (unsigned)DRYSUB : (unsigned)SUB;
        if (wg < 128) { if (SUBM & 1) dn_prompt(p, lds, tid, wave, lane, wg >> 2, wg & 3, dry); }
        else {
            if (SUBM & 2) copy_caches(p, wave, lane, wg - 128, G - 128);
            if (wg < 192) { const int u = wg - 128; if (SUBM & 4) dn_sample(p, lds, tid, wave, lane, u >> 2, u & 3, dry); }
            else { for (int u = wg - 192; u < 128; u += (G - 192)) if (SUBM & 8) attn_sample(p, lds, tid, wave, lane, u >> 3, u & 7, dry); }
        }
        __syncthreads();
        for (int i = tid; i < 8 * 257; i += NT) ((float*)(lds + AT_BIAS))[i] = p.in[15][i] * LOG2E;
        __syncthreads();
        for (;;) {
            int u = 0;
            if (lane == 0) u = (int)atomicAdd(ctl + rep, 1u);
            u = __builtin_amdgcn_readfirstlane(u);
            if (u >= 16384) break;
            if (SUBM & 16) { const int half_ = u & 1, c_ = (u >> 1) & 31, h_ = (u >> 6) & 7, b_ = u >> 9;
                attn_unit(p, lds, wave, lane, b_ * 512 + c_ * 16 + h_ * 2 + half_, dry); }
        }
        __syncthreads();
    }
    asm volatile("s_waitcnt vmcnt(0) lgkmcnt(0)" ::: "memory"); __syncthreads();
    xcd_barrier(xbar);
    RELAUNDER_IDS();
    if (PHMASK & (1u << 5))
    {
        pg8::Gemm g{big, (const bf16_t*)(ws + WS_WBA), MT, DM, 512, NPJ}; pg8::StaticOrder S; S.init(MT, DM, G, wg);
        pg8::EpiBranch<0> E{big, 3584};
        pg8::gemm_phase<pg8::EpiBranch<0>, pg8::StaticOrder, true, true>(lds3, g, S, E);
        pg8::Gemm g2{big + 3072, (const bf16_t*)(ws + WS_WBB), MT, DM, 512, NPJ};
        pg8::EpiBranch<1> E2{big, 4608};
        pg8::gemm_phase<pg8::EpiBranch<1>, pg8::StaticOrder, true, true>(lds3, g2, S, E2);
    }
    asm volatile("s_waitcnt vmcnt(0) lgkmcnt(0)" ::: "memory"); __syncthreads();
    xcd_barrier(xbar);
    RELAUNDER_IDS();
    if (PHMASK & (1u << 6))
    {
        pg8::Gemm g{big + 512, (const bf16_t*)(ws + WS_WMIX), MT, DM, DM, NPJ}; pg8::StaticOrder S; S.init(MT, DM, G, wg);
        pg8::EpiRes E{xo, xo + (size_t)MP * DM, xo, xb, ss2, 1.0f};
        pg8::gemm_phase<pg8::EpiRes, pg8::StaticOrder, true, true>(lds3, g, S, E);
    }
    asm volatile("s_waitcnt vmcnt(0) lgkmcnt(0)" ::: "memory"); __syncthreads();
    xcd_barrier(xbar);
    RELAUNDER_IDS();
    if (PHMASK & (1u << 7))
    {
        pg8::Gemm g{xb, (const bf16_t*)(ws + WS_WQ), MT, DM, DM, DM}; pg8::StaticOrder S; S.init(MT, DM, G, wg);
        pg8::EpiScale E{(bf16_t*)(ws + WS_QX), DM, ss2, 0.0625f * LOG2E};
        pg8::gemm_phase<pg8::EpiScale, pg8::StaticOrder, true, true>(lds3, g, S, E);
    }
    asm volatile("s_waitcnt vmcnt(0) lgkmcnt(0)" ::: "memory"); __syncthreads();
    xcd_barrier(xbar);
    RELAUNDER_IDS();
    if (PHMASK & (1u << 8))
    {
        const bf16_t* qx = (const bf16_t*)(ws + WS_QX); bf16_t* ox = (bf16_t*)(ws + WS_OX);
        const bf16_t* memk = (const bf16_t*)(ws + WS_MEMK); const bf16_t* memv = (const bf16_t*)(ws + WS_MEMV);
        for (int bh = wg >> 1; bh < 128; bh += (G >> 1)) {
            const int b = bh >> 2, h = bh & 3;
            xattn_stage_v(memv, lds, tid, (size_t)b * 256, h);
            for (int qi = 0; qi < 4; ++qi) { const int qt = (wg & 1) * 4 + qi;
                for (int dh = 0; dh < 2; ++dh) xattn_unit_k(qx, memk, ox, lds, tid, lane, (size_t)b * 2048 + qt * 256 + wave * 32, (size_t)b * 256, h, 32, dh); }
        }
        for (int u = wg; u < 64; u += G) {
            const int b = u >> 2, h = u & 3;
            xattn_stage_v(memv, lds, tid, (size_t)8192 + b * 256, h);
            for (int dh = 0; dh < 2; ++dh) xattn_unit_k(qx, memk, ox, lds, tid, lane, (size_t)MP + b * 16, (size_t)8192 + b * 256, h, wave == 0 ? 16 : 0, dh);
        }
        __syncthreads();
    }
    asm volatile("s_waitcnt vmcnt(0) lgkmcnt(0)" ::: "memory"); __syncthreads();
    xcd_barrier(xbar);
    RELAUNDER_IDS();
    if (PHMASK & (1u << 9))
    {
        pg8::Gemm g{(const bf16_t*)(ws + WS_OX), (const bf16_t*)(ws + WS_WO), MT, DM, DM, DM}; pg8::StaticOrder S; S.init(MT, DM, G, wg);
        pg8::EpiRes E{xo, xo + (size_t)MP * DM, xo, xb, ss3, 1.0f};
        pg8::gemm_phase<pg8::EpiRes, pg8::StaticOrder, true, true>(lds3, g, S, E);
    }
    asm volatile("s_waitcnt vmcnt(0) lgkmcnt(0)" ::: "memory"); __syncthreads();
    xcd_barrier(xbar);
    RELAUNDER_IDS();
    if (PHMASK & (1u << 10))
    {
        pg8::Gemm g{xb, (const bf16_t*)(ws + WS_WGU2), MT, 2 * DFF, DM, DM}; pg8::StaticOrder S; S.init(MT, 2 * DFF, G, wg);
        pg8::EpiSwiglu E{big, DFF, ss3};
        pg8::gemm_phase<pg8::EpiSwiglu, pg8::StaticOrder, true, true>(lds3, g, S, E);
    }
    asm volatile("s_waitcnt vmcnt(0) lgkmcnt(0)" ::: "memory"); __syncthreads();
    xcd_barrier(xbar);
    RELAUNDER_IDS();
    if (PHMASK & (1u << 11))
    {
        pg8::Gemm g{big, (const bf16_t*)(ws + WS_WD2), MT, DM, DFF, DFF}; pg8::StaticOrder S; S.init(MT, DM, G, wg);
        pg8::EpiRes E{xo, xo + (size_t)MP * DM, xo, nullptr, ss4, 0.5f};
        pg8::gemm_phase<pg8::EpiRes, pg8::StaticOrder, true, true>(lds3, g, S, E);
    }
    asm volatile("s_waitcnt vmcnt(0) lgkmcnt(0)" ::: "memory"); __syncthreads();
    xcd_barrier(xbar);
    RELAUNDER_IDS();
    if (PHMASK & (1u << 12))
    for (int m = gw; m < MT; m += NGW) {
        const float rs = pg8::rstd16(ss4, m);
        f32x4* xr = (f32x4*)(xo + (size_t)m * DM) + lane; const f32x4* gr = (const f32x4*)p.in[33] + lane;
#pragma unroll
        for (int j = 0; j < 4; ++j) { const f32x4 v = xr[64 * j], gg = gr[64 * j]; xr[64 * j] = v * rs * gg; }
    }
}

extern "C" void kernel_launch(void* const* d_in, const int* in_sizes, int n_in, void* d_out, int out_size, void* d_ws, size_t ws_size, hipStream_t stream) {
    static int grid = 0;
    if (grid == 0) {
        if (n_in != 34 || (size_t)out_size != O_END || ws_size < WS_END) { fprintf(stderr, "kernel_launch: unexpected shapes: n_in %d out %d ws %zu (need %zu)\n", n_in, out_size, ws_size, (size_t)WS_END); grid = -1; return; }
        int dev = 0, cus = 0, per_cu = 0;
        hipGetDevice(&dev); hipDeviceGetAttribute(&cus, hipDeviceAttributeMultiprocessorCount, dev);
        if (hipFuncSetAttribute((const void*)hybrid_fwd, hipFuncAttributeMaxDynamicSharedMemorySize, LDS_BYTES) != hipSuccess) { fprintf(stderr, "kernel_launch: hipFuncSetAttribute failed\n"); grid = -1; return; }
        if (hipOccupancyMaxActiveBlocksPerMultiprocessor(&per_cu, (const void*)hybrid_fwd, NT, LDS_BYTES) != hipSuccess || per_cu < 1) { fprintf(stderr, "kernel_launch: occupancy query says %d\n", per_cu); per_cu = 1; }
        (void)hipGetLastError();
        grid = cus;
        if (grid < 192 || (grid & 1)) { fprintf(stderr, "kernel_launch: unsupported CU count %d\n", grid); grid = -1; return; }
    }
    if (grid < 0) return;
    hipMemsetAsync((char*)d_ws + WS_CTL, 0, 65536, stream);
    Prm prm{};
    for (int i = 0; i < 34; ++i) prm.in[i] = (const float*)d_in[i];
    prm.out = (float*)d_out; prm.ws = (unsigned char*)d_ws;
    void* args[] = {&prm};
    hipError_t e = hipLaunchCooperativeKernel((const void*)hybrid_fwd, dim3(grid), dim3(NT), args, LDS_BYTES, stream);
    if (e != hipSuccess) fprintf(stderr, "kernel_launch: cooperative launch failed: %s (grid %d)\n", hipGetErrorString(e), grid);
}
```

```cpp
#include <hip/hip_runtime.h>
#include <hip/hip_cooperative_groups.h>
#include <cstdio>
#include <cstdint>
namespace cg = cooperative_groups;

#define DI __device__ __forceinline__
typedef float f32x16 __attribute__((ext_vector_type(16)));
typedef unsigned u32x2 __attribute__((ext_vector_type(2)));

namespace pg8 {
#define PG8_LAS __attribute__((address_space(3)))
typedef unsigned short bf16_t;
typedef short bf16x8 __attribute__((ext_vector_type(8)));
typedef float f32x4 __attribute__((ext_vector_type(4)));
typedef unsigned u32x4 __attribute__((ext_vector_type(4)));
constexpr int BM = 256, BK = 64, HALF = 128, HTB = HALF * BK * 2  , STAGE_BYTES = 8 * HTB, NXCD = 8, WGM = 8;

__host__ __device__ __forceinline__ int lds_byte(int r, int c) { const int st = (r >> 4) * 2 + (c >> 5), rr = r & 15, cc = c & 31, ob = rr * 64 + cc * 2; return st * 1024 + (ob ^ (((ob >> 9) & 1) << 5)); }
__host__ __device__ __forceinline__ void stage_rc(int b, int& R, int& C) { const int st = b / 1024, sb = b % 1024, swz = sb ^ (((sb >> 9) & 1) << 5); R = (st >> 1) * 16 + swz / 64; C = (st & 1) * 32 + (swz % 64) / 2; }
__host__ __device__ __forceinline__ int perm32(int rho) { const int n = rho >> 4, i = rho & 15; return 8 * (i >> 2) + 4 * n + (i & 3); }

struct Unit { int pm, pn; };
struct Gemm { const bf16_t* A; const bf16_t* Bt; int M, N, K, lda; };

struct StaticOrder {
    int nM, nN, nwg, G, c;
    __host__ __device__ void init(int M, int N, int G_, int c_) { nM = M / BM; nN = N / BM; nwg = nM * nN; G = G_; c = c_; }
    __host__ __device__ bool next(int i, Unit& u) const {
        const long L = (long)i * G + c; if (L >= nwg) return false;
        int wgid = (int)L; { const int q = nwg / NXCD, r = nwg % NXCD, xcd = wgid % NXCD, off = wgid / NXCD; wgid = (xcd < r ? xcd * (q + 1) : r * (q + 1) + (xcd - r) * q) + off; }
        const int nig = WGM * nN, gid = wgid / nig, fm = gid * WGM, gsz = (nM - fm) < WGM ? (nM - fm) : WGM;
        u.pm = fm + ((wgid % nig) % gsz); u.pn = (wgid % nig) / gsz; return true;
    }
    __device__ __forceinline__ void a_ready(const Unit&) const {}
    __device__ __forceinline__ void done(const Unit&) const {}
};


__device__ __forceinline__ unsigned cvt_pk_bf16(float lo, float hi) { unsigned r; asm("v_cvt_pk_bf16_f32 %0, %1, %2" : "=v"(r) : "v"(lo), "v"(hi)); return r; }
__device__ __forceinline__ float bflo(unsigned u) { return __uint_as_float(u << 16); }
__device__ __forceinline__ float bfhi(unsigned u) { return __uint_as_float(u & 0xffff0000u); }
__device__ __forceinline__ float rstd16(const float* ss, int row) {
    const f32x4* p = (const f32x4*)(ss + (size_t)row * 16);
    const f32x4 a = p[0], b = p[1], c = p[2], d = p[3];
    const float s = (((a[0] + a[1]) + (a[2] + a[3])) + ((b[0] + b[1]) + (b[2] + b[3]))) + (((c[0] + c[1]) + (c[2] + c[3])) + ((d[0] + d[1]) + (d[2] + d[3])));
    return rsqrtf(s * (1.0f / 1024.0f) + 1e-6f);
}
__device__ __forceinline__ float silu_f(float g) { return g * __builtin_amdgcn_rcpf(1.0f + __expf(-g)); }
__device__ __forceinline__ float sigm_f(float g) { return __builtin_amdgcn_rcpf(1.0f + __expf(-g)); }

struct EpiSwiglu {
    static constexpr bool PERM = true, AFTER_DRAIN = false;
    bf16_t* O; int ldc; const float* ss;
    __device__ __forceinline__ void operator()(const f32x4 (&acc)[2][2][4][2], const Unit& u, int wr, int wc, int fr, int fq) const {
        const int row0 = u.pm * BM + wr * 64 + fr, col0 = u.pn * 128 + wc * 32 + 8 * fq;
#pragma unroll
        for (int ai = 0; ai < 2; ++ai)
#pragma unroll
            for (int m = 0; m < 4; ++m) {
                const int row = row0 + ai * HALF + m * 16; const float rs = rstd16(ss, row);
                float h[8];
#pragma unroll
                for (int n = 0; n < 2; ++n)
#pragma unroll
                    for (int j = 0; j < 4; ++j) { const float g = acc[ai][0][m][n][j] * rs, up = acc[ai][1][m][n][j] * rs; h[4 * n + j] = silu_f(g) * up; }
                u32x4 w; w.x = cvt_pk_bf16(h[0], h[1]); w.y = cvt_pk_bf16(h[2], h[3]); w.z = cvt_pk_bf16(h[4], h[5]); w.w = cvt_pk_bf16(h[6], h[7]);
                *(u32x4*)(O + (size_t)row * ldc + col0) = w;
            }
    }
};
struct EpiScale {
    static constexpr bool PERM = true, AFTER_DRAIN = false;
    bf16_t* O; int ldc; const float* ss; float cs;
    __device__ __forceinline__ void operator()(const f32x4 (&acc)[2][2][4][2], const Unit& u, int wr, int wc, int fr, int fq) const {
        const int row0 = u.pm * BM + wr * 64 + fr, col0 = u.pn * BM + wc * 32 + 8 * fq;
#pragma unroll
        for (int ai = 0; ai < 2; ++ai)
#pragma unroll
            for (int m = 0; m < 4; ++m) {
                const int row = row0 + ai * HALF + m * 16; const float rs = (ss ? rstd16(ss, row) : 1.0f) * cs;
#pragma unroll
                for (int bj = 0; bj < 2; ++bj) { const f32x4 v0 = acc[ai][bj][m][0] * rs, v1 = acc[ai][bj][m][1] * rs;
                    u32x4 w; w.x = cvt_pk_bf16(v0[0], v0[1]); w.y = cvt_pk_bf16(v0[2], v0[3]); w.z = cvt_pk_bf16(v1[0], v1[1]); w.w = cvt_pk_bf16(v1[2], v1[3]);
                    *(u32x4*)(O + (size_t)row * ldc + col0 + bj * HALF) = w; }
            }
    }
};
struct EpiRes {
    static constexpr bool PERM = false, AFTER_DRAIN = false;
    const float* srcP; const float* srcS; float* dst; bf16_t* xb; float* ssout; float alpha;
    __device__ __forceinline__ void operator()(const f32x4 (&acc)[2][2][4][2], const Unit& u, int wr, int wc, int fr, int fq) const {
        const int row0 = u.pm * BM + wr * 64 + fr, col0 = u.pn * BM + wc * 32 + 4 * fq;
#pragma unroll
        for (int ai = 0; ai < 2; ++ai)
#pragma unroll
            for (int m = 0; m < 4; ++m) {
                const int row = row0 + ai * HALF + m * 16;
                const float* sp = (row < 65536) ? srcP + (size_t)row * 1024 : srcS + (size_t)(row - 65536) * 1024;
                float s = 0.f;
#pragma unroll
                for (int bj = 0; bj < 2; ++bj)
#pragma unroll
                    for (int n = 0; n < 2; ++n) {
                        const int col = col0 + bj * HALF + n * 16;
                        const f32x4 xo = *(const f32x4*)(sp + col);
                        const f32x4 v = xo + acc[ai][bj][m][n] * alpha;
                        *(f32x4*)(dst + (size_t)row * 1024 + col) = v;
                        s += (v[0] * v[0] + v[1] * v[1]) + (v[2] * v[2] + v[3] * v[3]);
                        if (xb) { u32x2 w; w.x = cvt_pk_bf16(v[0], v[1]); w.y = cvt_pk_bf16(v[2], v[3]); *(u32x2*)(xb + (size_t)row * 1024 + col) = w; }
                    }
                s += __shfl_xor(s, 16); s += __shfl_xor(s, 32);
                if (fq == 0) ssout[(size_t)row * 16 + u.pn * 4 + wc] = s;
            }
    }
};
struct EpiMemKV {
    static constexpr bool PERM = false, AFTER_DRAIN = false;
    float* outK; float* outV; bf16_t* kb; bf16_t* vb; const float* ssm;
    __device__ __forceinline__ void operator()(const f32x4 (&acc)[2][2][4][2], const Unit& u, int wr, int wc, int fr, int fq) const {
        const int row0 = u.pm * BM + wr * 64 + fr; const bool isv = u.pn >= 4; const int col0 = (u.pn & 3) * BM + wc * 32 + 4 * fq;
        float* of = isv ? outV : outK; bf16_t* ob = isv ? vb : kb;
#pragma unroll
        for (int ai = 0; ai < 2; ++ai)
#pragma unroll
            for (int m = 0; m < 4; ++m) {
                const int row = row0 + ai * HALF + m * 16; const float rs = rsqrtf(ssm[row] * (1.0f / 1024.0f) + 1e-6f);
#pragma unroll
                for (int bj = 0; bj < 2; ++bj)
#pragma unroll
                    for (int n = 0; n < 2; ++n) {
                        const int col = col0 + bj * HALF + n * 16; const f32x4 v = acc[ai][bj][m][n] * rs;
                        *(f32x4*)(of + (size_t)row * 1024 + col) = v;
                        u32x2 w; w.x = cvt_pk_bf16(v[0], v[1]); w.y = cvt_pk_bf16(v[2], v[3]); *(u32x2*)(ob + (size_t)row * 1024 + col) = w;
                    }
            }
    }
};
template <int PASS> struct EpiBranch {
    static constexpr bool PERM = true, AFTER_DRAIN = false;
    bf16_t* proj; int gcol;
    __device__ __forceinline__ void operator()(const f32x4 (&acc)[2][2][4][2], const Unit& u, int wr, int wc, int fr, int fq) const {
        const int row0 = u.pm * BM + wr * 64 + fr, col0 = u.pn * BM + wc * 32 + 8 * fq;
#pragma unroll
        for (int ai = 0; ai < 2; ++ai)
#pragma unroll
            for (int m = 0; m < 4; ++m) {
                bf16_t* rp = proj + (size_t)(row0 + ai * HALF + m * 16) * 5632;
#pragma unroll
                for (int bj = 0; bj < 2; ++bj) {
                    const int c = col0 + bj * HALF;
                    const u32x4 gv = *(const u32x4*)(rp + gcol + c);
                    float o[8];
                    o[0] = sigm_f(bflo(gv.x)) * acc[ai][bj][m][0][0]; o[1] = sigm_f(bfhi(gv.x)) * acc[ai][bj][m][0][1];
                    o[2] = sigm_f(bflo(gv.y)) * acc[ai][bj][m][0][2]; o[3] = sigm_f(bfhi(gv.y)) * acc[ai][bj][m][0][3];
                    o[4] = sigm_f(bflo(gv.z)) * acc[ai][bj][m][1][0]; o[5] = sigm_f(bfhi(gv.z)) * acc[ai][bj][m][1][1];
                    o[6] = sigm_f(bflo(gv.w)) * acc[ai][bj][m][1][2]; o[7] = sigm_f(bfhi(gv.w)) * acc[ai][bj][m][1][3];
                    if (PASS == 1) { const u32x4 tv = *(const u32x4*)(rp + 512 + c);
                        o[0] += bflo(tv.x); o[1] += bfhi(tv.x); o[2] += bflo(tv.y); o[3] += bfhi(tv.y); o[4] += bflo(tv.z); o[5] += bfhi(tv.z); o[6] += bflo(tv.w); o[7] += bfhi(tv.w); }
                    u32x4 w; w.x = cvt_pk_bf16(o[0], o[1]); w.y = cvt_pk_bf16(o[2], o[3]); w.z = cvt_pk_bf16(o[4], o[5]); w.w = cvt_pk_bf16(o[6], o[7]);
                    *(u32x4*)(rp + 512 + c) = w;
                }
            }
    }
};

template <class Epi, class Sched, bool ALIGN_EPI = false, bool SP2 = false>
__device__ __forceinline__ void gemm_phase(PG8_LAS unsigned char* lds, const Gemm g, const Sched& S, const Epi& E) {
    int tid_l = threadIdx.x; asm volatile("" : "+v"(tid_l));
    const int tid = tid_l, wid = __builtin_amdgcn_readfirstlane(tid >> 6), lane = tid & 63, wr = wid >> 2, wc = wid & 3, fr = lane & 15, fq = lane >> 4;
    const int K = g.K, nt = K / BK;
    unsigned voffA[2], voffB[2];
#pragma unroll
    for (int i = 0; i < 2; ++i) { int R, C; stage_rc(tid * 16 + i * 8192, R, C); const int Rb = Epi::PERM ? ((R & ~31) + perm32(R & 31)) : R;
        voffA[i] = (unsigned)(R * g.lda + C) * 2u; voffB[i] = (unsigned)(Rb * K + C) * 2u; }
    const size_t kstep = (size_t)(BK * 2);
    const size_t hstep = (size_t)HALF * K * 2;
    const size_t tstep = 2 * hstep; const size_t hstepA = (size_t)HALF * g.lda * 2, tstepA = 2 * hstepA;
    const unsigned ldsw = (unsigned)wid * 1024u;
    const int aoff = lds_byte(wr * 64 + fr, fq * 8), boff = lds_byte(wc * 32 + fr, fq * 8);
#define PG8_SA(b, h) (((b) * 2 + (h)) * HTB)
#define PG8_SB(b, h) ((4 + (b) * 2 + (h)) * HTB)
#define PG8_STAGE(bufoff, gbase, voff) do { _Pragma("unroll") for (int _i = 0; _i < 2; ++_i) \
        __builtin_amdgcn_global_load_lds((const unsigned*)((const char*)(gbase) + (voff)[_i]), (PG8_LAS unsigned*)(lds + (bufoff) + ldsw + _i * 8192), 16, 0, 0); } while (0)
#define PG8_LDA(dst, b, h) do { _Pragma("unroll") for (int m = 0; m < 4; ++m) _Pragma("unroll") for (int k = 0; k < 2; ++k) dst[m][k] = *(const PG8_LAS bf16x8*)(lds + PG8_SA(b, h) + aoff + m * 2048 + k * 1024); } while (0)
#define PG8_LDB(dst, b, h) do { _Pragma("unroll") for (int n = 0; n < 2; ++n) _Pragma("unroll") for (int k = 0; k < 2; ++k) dst[n][k] = *(const PG8_LAS bf16x8*)(lds + PG8_SB(b, h) + boff + n * 2048 + k * 1024); } while (0)
#define PG8_MMA(ai, bj, At, Bt) do { __builtin_amdgcn_s_setprio(1); _Pragma("unroll") for (int m = 0; m < 4; ++m) _Pragma("unroll") for (int n = 0; n < 2; ++n) _Pragma("unroll") for (int k = 0; k < 2; ++k) \
        acc[ai][bj][m][n] = __builtin_amdgcn_mfma_f32_16x16x32_bf16(Bt[n][k], At[m][k], acc[ai][bj][m][n], 0, 0, 0); __builtin_amdgcn_s_setprio(0); } while (0)
#define PG8_WAIT_V(n) asm volatile("s_waitcnt vmcnt(" #n ")" ::: "memory")
#define PG8_WAIT_L(n) asm volatile("s_waitcnt lgkmcnt(" #n ")" ::: "memory")
#define PG8_BAR __builtin_amdgcn_s_barrier()
#define PG8_SCHED __builtin_amdgcn_sched_barrier(0)
    Unit cur, nxt; int ui = 0;
    if (!S.next(0, cur)) return;
    f32x4 acc[2][2][4][2];
#pragma unroll
    for (int a = 0; a < 2; ++a)
#pragma unroll
        for (int b = 0; b < 2; ++b)
#pragma unroll
            for (int m = 0; m < 4; ++m)
#pragma unroll
                for (int n = 0; n < 2; ++n) acc[a][b][m][n] = (f32x4){0.f, 0.f, 0.f, 0.f};
    bf16x8 At[4][2], B0[2][2], B1[2][2];
    const char* cA = (const char*)g.A + (size_t)cur.pm * tstepA; const char* cB = (const char*)g.Bt + (size_t)cur.pn * tstep;
    S.a_ready(cur);
    if constexpr (SP2) {
        PG8_STAGE(PG8_SB(0, 0), cB, voffB); PG8_STAGE(PG8_SB(0, 1), cB + hstep, voffB); PG8_STAGE(PG8_SA(0, 0), cA, voffA); PG8_STAGE(PG8_SA(0, 1), cA + hstepA, voffA);
        if (wr == 1) PG8_BAR;
        PG8_WAIT_V(2); PG8_BAR;
        PG8_STAGE(PG8_SB(1, 0), cB + kstep, voffB); PG8_STAGE(PG8_SA(1, 0), cA + kstep, voffA); PG8_STAGE(PG8_SB(1, 1), cB + hstep + kstep, voffB);
        PG8_WAIT_V(6); PG8_BAR;
    } else {
        PG8_STAGE(PG8_SB(0, 0), cB, voffB); PG8_STAGE(PG8_SA(0, 0), cA, voffA); PG8_STAGE(PG8_SB(0, 1), cB + hstep, voffB); PG8_STAGE(PG8_SA(0, 1), cA + hstepA, voffA);
        if (wr == 1) PG8_BAR;
        PG8_WAIT_V(4); PG8_BAR;
        PG8_STAGE(PG8_SB(1, 0), cB + kstep, voffB); PG8_STAGE(PG8_SA(1, 0), cA + kstep, voffA); PG8_STAGE(PG8_SB(1, 1), cB + hstep + kstep, voffB);
        PG8_WAIT_V(6); PG8_BAR;
    }
    for (;;) {
        const bool has_next = S.next(ui + 1, nxt);
        const char* nA = has_next ? (const char*)g.A + (size_t)nxt.pm * tstepA : cA; const char* nB = has_next ? (const char*)g.Bt + (size_t)nxt.pn * tstep : cB;
        for (int t = 0; t < nt; t += 2) {
            const bool last = (t == nt - 2);
            const char* a1 = cA + (size_t)(t + 1) * kstep;
            const char* a2 = last ? nA : cA + (size_t)(t + 2) * kstep; const char* b2 = last ? nB : cB + (size_t)(t + 2) * kstep;
            const char* a3 = a2 + kstep; const char* b3 = b2 + kstep;
            if (last && has_next) S.a_ready(nxt);
            if constexpr (SP2) {
            PG8_LDB(B0, 0, 0); PG8_LDB(B1, 0, 1); PG8_SCHED; PG8_LDA(At, 0, 0); PG8_STAGE(PG8_SA(1, 1), a1 + hstepA, voffA);
            PG8_WAIT_V(8); PG8_WAIT_L(0); PG8_BAR; PG8_MMA(0, 0, At, B0); PG8_MMA(0, 1, At, B1); PG8_BAR; PG8_SCHED;
            PG8_LDA(At, 0, 1); PG8_STAGE(PG8_SB(0, 0), b2, voffB); PG8_STAGE(PG8_SB(0, 1), b2 + hstep, voffB); PG8_STAGE(PG8_SA(0, 0), a2, voffA);
            PG8_WAIT_V(8); PG8_WAIT_L(0); PG8_BAR; PG8_MMA(1, 0, At, B0); PG8_MMA(1, 1, At, B1); PG8_BAR; PG8_SCHED;
            PG8_LDB(B0, 1, 0); PG8_LDB(B1, 1, 1); PG8_SCHED; PG8_LDA(At, 1, 0); PG8_STAGE(PG8_SA(0, 1), a2 + hstepA, voffA);
            PG8_WAIT_V(8); PG8_WAIT_L(0); PG8_BAR; PG8_MMA(0, 0, At, B0); PG8_MMA(0, 1, At, B1); PG8_BAR; PG8_SCHED;
            PG8_LDA(At, 1, 1); PG8_STAGE(PG8_SB(1, 0), b3, voffB); PG8_STAGE(PG8_SB(1, 1), b3 + hstep, voffB); PG8_STAGE(PG8_SA(1, 0), a3, voffA);
            PG8_WAIT_V(8); PG8_WAIT_L(0); PG8_BAR; PG8_MMA(1, 0, At, B0); PG8_MMA(1, 1, At, B1); PG8_BAR; PG8_SCHED;
            } else {
            PG8_LDB(B0, 0, 0); PG8_SCHED; PG8_LDA(At, 0, 0); PG8_STAGE(PG8_SA(1, 1), a1 + hstepA, voffA);
            PG8_WAIT_L(8); PG8_BAR; PG8_WAIT_L(0); PG8_MMA(0, 0, At, B0); PG8_BAR; PG8_SCHED;
            PG8_LDB(B1, 0, 1); PG8_STAGE(PG8_SB(0, 0), b2, voffB);
            PG8_BAR; PG8_WAIT_L(0); PG8_MMA(0, 1, At, B1); PG8_BAR;
            PG8_LDA(At, 0, 1); PG8_STAGE(PG8_SA(0, 0), a2, voffA);
            PG8_BAR; PG8_WAIT_L(0); PG8_MMA(1, 0, At, B0); PG8_BAR; PG8_SCHED;
            PG8_STAGE(PG8_SB(0, 1), b2 + hstep, voffB);
            PG8_WAIT_V(6); PG8_BAR; PG8_MMA(1, 1, At, B1); PG8_BAR;
            PG8_LDB(B0, 1, 0); PG8_SCHED; PG8_LDA(At, 1, 0); PG8_STAGE(PG8_SA(0, 1), a2 + hstepA, voffA);
            PG8_WAIT_L(8); PG8_BAR; PG8_WAIT_L(0); PG8_MMA(0, 0, At, B0); PG8_BAR; PG8_SCHED;
            PG8_LDB(B1, 1, 1); PG8_STAGE(PG8_SB(1, 0), b3, voffB);
            PG8_BAR; PG8_WAIT_L(0); PG8_MMA(0, 1, At, B1); PG8_BAR;
            PG8_LDA(At, 1, 1); PG8_STAGE(PG8_SA(1, 0), a3, voffA);
            PG8_BAR; PG8_WAIT_L(0); PG8_MMA(1, 0, At, B0); PG8_BAR; PG8_SCHED;
            PG8_STAGE(PG8_SB(1, 1), b3 + hstep, voffB);
            PG8_WAIT_V(6); PG8_BAR; PG8_MMA(1, 1, At, B1); PG8_BAR;
            }
        }
        if constexpr (ALIGN_EPI) { if (wr == 0) PG8_BAR; }
        if constexpr (!Epi::AFTER_DRAIN) { E(acc, cur, wr, wc, fr, fq); S.done(cur); }
        if (!has_next) break;
#pragma unroll
        for (int a = 0; a < 2; ++a)
#pragma unroll
            for (int b = 0; b < 2; ++b)
#pragma unroll
                for (int m = 0; m < 4; ++m)
#pragma unroll
                    for (int n = 0; n < 2; ++n) acc[a][b][m][n] = (f32x4){0.f, 0.f, 0.f, 0.f};
        cur = nxt; cA = nA; cB = nB; ++ui;
        if constexpr (ALIGN_EPI) { if (wr == 1) PG8_BAR; }
    }
    PG8_WAIT_V(0);
    if constexpr (!ALIGN_EPI) { if (wr == 0) PG8_BAR; }
    PG8_BAR;
    if constexpr (Epi::AFTER_DRAIN) { E.fused(acc, cur, wr, wc, fr, fq, lds, wid, lane); S.done(cur); }
#undef PG8_SA
#undef PG8_SB
#undef PG8_STAGE
#undef PG8_LDA
#undef PG8_LDB
#undef PG8_MMA
#undef PG8_WAIT_V
#undef PG8_WAIT_L
#undef PG8_BAR
#undef PG8_SCHED
}
}

using pg8::bf16_t; using pg8::bf16x8; using pg8::f32x4; using pg8::u32x4; using pg8::cvt_pk_bf16; using pg8::bflo; using pg8::bfhi; using pg8::silu_f; using pg8::sigm_f;
constexpr int MP = 65536, MS = 256, MT = MP + MS;
constexpr int DM = 1024, DFF = 2816, NPJ = 5632, NIN = 5640;
constexpr size_t MiB = 1u << 20;
constexpr size_t WS_CTL = 0;
constexpr size_t WS_WGU1 = 1 * MiB, WS_WD1 = 13 * MiB, WS_WIN = 19 * MiB, WS_WBA = 31 * MiB, WS_WBB = 32 * MiB, WS_WMIX = 33 * MiB, WS_WQ = 35 * MiB, WS_WO = 37 * MiB,
                 WS_WKV = 39 * MiB, WS_WGU2 = 43 * MiB, WS_WD2 = 55 * MiB;
constexpr size_t WS_SS = 65 * MiB, SS_STRIDE = 5 * MiB;
constexpr size_t WS_SSM = 90 * MiB;
constexpr size_t WS_BD = 91 * MiB;
constexpr size_t WS_MEMB = 94 * MiB;
constexpr size_t WS_MEMK = 110 * MiB, WS_MEMV = 134 * MiB;
constexpr size_t WS_XB = 158 * MiB;
constexpr size_t WS_BIG = 287 * MiB;
constexpr size_t WS_QX = WS_BIG, WS_OX = WS_BIG + 160 * MiB;
constexpr size_t WS_END = WS_BIG + 708 * MiB;
constexpr size_t O_Y = 0, O_PAK = (size_t)MT * DM, O_PAV = O_PAK + 8388608, O_PBC = O_PAV + 8388608, O_PBS = O_PBC + 147456, O_PMK = O_PBS + 2097152, O_PMV = O_PMK + 8388608,
                 O_SAK = O_PMV + 8388608, O_SAV = O_SAK + 131072, O_SBC = O_SAV + 131072, O_SBS = O_SBC + 73728, O_END = O_SBS + 1048576;
constexpr int LDS_BYTES = 163840;
constexpr int NT = 512;

struct Prm { const float* in[34]; float* out; unsigned char* ws; };

DI float dpp_ror(float v, int) { return v; }
#define DPP_ROR(v, n) __builtin_bit_cast(float, __builtin_amdgcn_update_dpp(0, __builtin_bit_cast(int, (v)), 0x120 + (n), 0xf, 0xf, false))
DI float wave_sum(float v) {
    v += DPP_ROR(v, 8); v += DPP_ROR(v, 4); v += DPP_ROR(v, 2); v += DPP_ROR(v, 1);
    const int iv = __builtin_bit_cast(int, v);
    const float a = __builtin_bit_cast(float, __builtin_amdgcn_readlane(iv, 0)), b = __builtin_bit_cast(float, __builtin_amdgcn_readlane(iv, 16));
    const float c = __builtin_bit_cast(float, __builtin_amdgcn_readlane(iv, 32)), d = __builtin_bit_cast(float, __builtin_amdgcn_readlane(iv, 48));
    return (a + b) + (c + d);
}
DI float bf2f(bf16_t h) { return __uint_as_float((unsigned)h << 16); }
#define MFMA32(a, b, c) __builtin_amdgcn_mfma_f32_32x32x16_bf16((a), (b), (c), 0, 0, 0)
DI int crow(int r, int h) { return (r & 3) + 8 * (r >> 2) + 4 * h; }
DI bf16x8 pack8(const f32x16& p, int s) {
    u32x4 w; w.x = cvt_pk_bf16(p[8 * s + 0], p[8 * s + 1]); w.y = cvt_pk_bf16(p[8 * s + 2], p[8 * s + 3]); w.z = cvt_pk_bf16(p[8 * s + 4], p[8 * s + 5]); w.w = cvt_pk_bf16(p[8 * s + 6], p[8 * s + 7]);
    return __builtin_bit_cast(bf16x8, w);
}
DI int kslot(int kk) { return 8 * ((kk >> 2) & 1) + 4 * (kk >> 3) + (kk & 3); }

DI void tr_item(const float* Wc, int ld, const float* gain, int k0, bf16_t* dst, int K, float* scr, int lane) {
#pragma unroll 8
    for (int i = 0; i < 32; ++i) { const int kk = 2 * i + (lane >> 5); float v = Wc[(size_t)(k0 + kk) * ld + (lane & 31)]; if (gain) v *= gain[k0 + kk]; scr[kk * 33 + (lane & 31)] = v; }
    __builtin_amdgcn_wave_barrier(); asm volatile("s_waitcnt lgkmcnt(0)" ::: "memory");
    const int c = lane & 7;
#pragma unroll
    for (int j = 0; j < 4; ++j) { const int n = (lane >> 3) + 8 * j; const float* s = scr + (8 * c) * 33 + n;
        u32x4 o; o.x = cvt_pk_bf16(s[0 * 33], s[1 * 33]); o.y = cvt_pk_bf16(s[2 * 33], s[3 * 33]); o.z = cvt_pk_bf16(s[4 * 33], s[5 * 33]); o.w = cvt_pk_bf16(s[6 * 33], s[7 * 33]);
        *(u32x4*)(dst + (size_t)n * K + k0 + 8 * c) = o; }
    __builtin_amdgcn_wave_barrier(); asm volatile("s_waitcnt lgkmcnt(0)" ::: "memory");
}
DI void phase0(const Prm& p, unsigned char* lds, int wave, int lane, int gw, int NGW) {
    float* scr = (float*)(lds + wave * 16384);
    unsigned char* ws = p.ws;
    for (int it = gw; it < 14336; it += NGW) {
        int r = it;
        if (r < 2816) { const int kb = r / 176, nb = r % 176, t = nb >> 3, w = nb & 7;
            tr_item((w < 4 ? p.in[10] : p.in[11]) + 128 * t + 32 * (w & 3), DFF, p.in[9], 64 * kb, (bf16_t*)(ws + WS_WGU1) + (size_t)(32 * nb) * 1024, 1024, scr, lane); continue; } r -= 2816;
        if (r < 1408) { const int kb = r / 32, nb = r % 32;
            tr_item(p.in[12] + 32 * nb, 1024, nullptr, 64 * kb, (bf16_t*)(ws + WS_WD1) + (size_t)(32 * nb) * DFF, DFF, scr, lane); continue; } r -= 1408;
        if (r < 2816) { const int kb = r / 176, nb = r % 176, c0 = 32 * nb, sc = c0 < 3584 ? c0 : c0 + 8;
            tr_item(p.in[14] + sc, NIN, p.in[13], 64 * kb, (bf16_t*)(ws + WS_WIN) + (size_t)c0 * 1024, 1024, scr, lane); continue; } r -= 2816;
        if (r < 256) { const int kb = r / 32, nb = r % 32;
            tr_item(p.in[20] + 32 * nb, 1024, nullptr, 64 * kb, (bf16_t*)(ws + WS_WBA) + (size_t)(32 * nb) * 512, 512, scr, lane); continue; } r -= 256;
        if (r < 256) { const int kb = r / 32, nb = r % 32;
            tr_item(p.in[21] + 32 * nb, 1024, nullptr, 64 * kb, (bf16_t*)(ws + WS_WBB) + (size_t)(32 * nb) * 512, 512, scr, lane); continue; } r -= 256;
        if (r < 512) { const int kb = r / 32, nb = r % 32;
            tr_item(p.in[22] + 32 * nb, 1024, nullptr, 64 * kb, (bf16_t*)(ws + WS_WMIX) + (size_t)(32 * nb) * 1024, 1024, scr, lane); continue; } r -= 512;
        if (r < 512) { const int kb = r / 32, nb = r % 32;
            tr_item(p.in[25] + 32 * nb, 1024, p.in[23], 64 * kb, (bf16_t*)(ws + WS_WQ) + (size_t)(32 * nb) * 1024, 1024, scr, lane); continue; } r -= 512;
        if (r < 512) { const int kb = r / 32, nb = r % 32;
            tr_item(p.in[28] + 32 * nb, 1024, nullptr, 64 * kb, (bf16_t*)(ws + WS_WO) + (size_t)(32 * nb) * 1024, 1024, scr, lane); continue; } r -= 512;
        if (r < 1024) { const int kb = r / 64, nb = r % 64;
            tr_item((nb < 32 ? p.in[26] + 32 * nb : p.in[27] + 32 * (nb - 32)), 1024, p.in[24], 64 * kb, (bf16_t*)(ws + WS_WKV) + (size_t)(32 * nb) * 1024, 1024, scr, lane); continue; } r -= 1024;
        if (r < 2816) { const int kb = r / 176, nb = r % 176, t = nb >> 3, w = nb & 7;
            tr_item((w < 4 ? p.in[30] : p.in[31]) + 128 * t + 32 * (w & 3), DFF, p.in[29], 64 * kb, (bf16_t*)(ws + WS_WGU2) + (size_t)(32 * nb) * 1024, 1024, scr, lane); continue; } r -= 2816;
        { const int kb = r / 32, nb = r % 32;
            tr_item(p.in[32] + 32 * nb, 1024, nullptr, 64 * kb, (bf16_t*)(ws + WS_WD2) + (size_t)(32 * nb) * DFF, DFF, scr, lane); }
    }
    bf16_t* xb = (bf16_t*)(ws + WS_XB); float* ss0 = (float*)(ws + WS_SS);
    for (int m = gw; m < MT; m += NGW) {
        const f32x4* xr = (const f32x4*)(m < MP ? p.in[0] + (size_t)m * DM : p.in[1] + (size_t)(m - MP) * DM) + lane;
        f32x4 v[4]; float s = 0.f;
#pragma unroll
        for (int j = 0; j < 4; ++j) { v[j] = xr[64 * j]; s += (v[j][0] * v[j][0] + v[j][1] * v[j][1]) + (v[j][2] * v[j][2] + v[j][3] * v[j][3]); }
        s = wave_sum(s);
        u32x2* o = (u32x2*)(xb + (size_t)m * DM) + lane;
#pragma unroll
        for (int j = 0; j < 4; ++j) { u32x2 w; w.x = cvt_pk_bf16(v[j][0], v[j][1]); w.y = cvt_pk_bf16(v[j][2], v[j][3]); o[64 * j] = w; }
        if (lane < 16) ss0[(size_t)m * 16 + lane] = lane == 0 ? s : 0.f;
    }
    bf16_t* memb = (bf16_t*)(ws + WS_MEMB); float* ssm = (float*)(ws + WS_SSM);
    for (int m = gw; m < 8192; m += NGW) {
        const f32x4* xr = (const f32x4*)(p.in[8] + (size_t)m * DM) + lane;
        f32x4 v[4]; float s = 0.f;
#pragma unroll
        for (int j = 0; j < 4; ++j) { v[j] = xr[64 * j]; s += (v[j][0] * v[j][0] + v[j][1] * v[j][1]) + (v[j][2] * v[j][2] + v[j][3] * v[j][3]); }
        s = wave_sum(s);
        u32x2* o = (u32x2*)(memb + (size_t)m * DM) + lane;
#pragma unroll
        for (int j = 0; j < 4; ++j) { u32x2 w; w.x = cvt_pk_bf16(v[j][0], v[j][1]); w.y = cvt_pk_bf16(v[j][2], v[j][3]); o[64 * j] = w; }
        if (lane == 0) ssm[m] = s;
    }
    for (int m = gw; m < 8192; m += NGW) {
        const int which = m >> 12, r = m & 4095;
        const f32x4* xr = (const f32x4*)(p.in[6 + which] + (size_t)r * DM) + lane;
        u32x2* o = (u32x2*)((bf16_t*)(ws + (which ? WS_MEMV : WS_MEMK)) + (size_t)(8192 + r) * DM) + lane;
#pragma unroll
        for (int j = 0; j < 4; ++j) { const f32x4 v = xr[64 * j]; u32x2 w; w.x = cvt_pk_bf16(v[0], v[1]); w.y = cvt_pk_bf16(v[2], v[3]); o[64 * j] = w; }
    }
}

DI void bd_pass(const Prm& p, unsigned char* lds, int tid, int wave, int lane, int gw, int NGW) {
    float* wt = (float*)lds;
    __syncthreads();
    for (int idx = tid; idx < 8192; idx += NT) { const int k = idx >> 3, j = idx & 7; wt[j * 1024 + k] = p.in[13][k] * p.in[14][(size_t)k * NIN + 3584 + j]; }
    __syncthreads();
    const bf16_t* xb = (const bf16_t*)(p.ws + WS_XB); const float* ss1 = (const float*)(p.ws + WS_SS + SS_STRIDE); float* bd = (float*)(p.ws + WS_BD);
    float ealog4[4], dtb4[4];
#pragma unroll
    for (int j = 0; j < 4; ++j) { ealog4[j] = __expf(p.in[17][j]); dtb4[j] = p.in[18][j]; }
    for (int m = gw; m < MT; m += NGW) {
        float acc[8];
#pragma unroll
        for (int j = 0; j < 8; ++j) acc[j] = 0.f;
#pragma unroll
        for (int hf = 0; hf < 2; ++hf) {
            const int k0 = 512 * hf + 8 * lane;
            const u32x4 xv = *(const u32x4*)(xb + (size_t)m * DM + k0);
            float x[8]; x[0] = bflo(xv.x); x[1] = bfhi(xv.x); x[2] = bflo(xv.y); x[3] = bfhi(xv.y); x[4] = bflo(xv.z); x[5] = bfhi(xv.z); x[6] = bflo(xv.w); x[7] = bfhi(xv.w);
#pragma unroll
            for (int j = 0; j < 8; ++j) { const f32x4 w0 = *(const f32x4*)(wt + j * 1024 + k0), w1 = *(const f32x4*)(wt + j * 1024 + k0 + 4);
                acc[j] += (x[0] * w0[0] + x[1] * w0[1]) + (x[2] * w0[2] + x[3] * w0[3]) + (x[4] * w1[0] + x[5] * w1[1]) + (x[6] * w1[2] + x[7] * w1[3]); }
        }
#pragma unroll
        for (int j = 0; j < 8; ++j) acc[j] = wave_sum(acc[j]);
        const float rs = pg8::rstd16(ss1, m);
        f32x4 ob, og;
#pragma unroll
        for (int j = 0; j < 4; ++j) {
            const float be = acc[j] * rs, de = acc[4 + j] * rs + dtb4[j];
            const float ee = __expf(de); const float sp = de > 20.f ? de : (de < -10.f ? ee : __logf(1.0f + ee));
            ob[j] = 1.0f / (1.0f + __expf(-be)); og[j] = -ealog4[j] * sp;
        }
        if (lane == 0) { *(f32x4*)(bd + (size_t)m * 8) = ob; *(f32x4*)(bd + (size_t)m * 8 + 4) = og; }
    }
    __syncthreads();
}

DI void copy_caches(const Prm& p, int wave, int lane, int wgi, int nwg) {
    const bf16_t* proj = (const bf16_t*)(p.ws + WS_BIG); float* out = p.out;
    const int gw = wgi * 8 + wave, NGW = nwg * 8;
    for (int it = gw; it < 16384 + 256; it += NGW) {
        size_t srow; float *dk, *dv;
        if (it < 16384) { const int b = it >> 9, t = it & 511; srow = (size_t)b * 2048 + 1536 + t; dk = out + O_PAK + (size_t)it * 512; dv = out + O_PAV + (size_t)it * 512; }
        else { const int r = it - 16384; srow = (size_t)MP + r; dk = out + O_SAK + (size_t)r * 512; dv = out + O_SAV + (size_t)r * 512; }
        const bf16_t* sp = proj + srow * NPJ + 512;
        const u32x4 kv = *(const u32x4*)(sp + 8 * lane), vv = *(const u32x4*)(sp + 512 + 8 * lane);
        f32x4 a, b;
        a[0] = bflo(kv.x); a[1] = bfhi(kv.x); a[2] = bflo(kv.y); a[3] = bfhi(kv.y); b[0] = bflo(kv.z); b[1] = bfhi(kv.z); b[2] = bflo(kv.w); b[3] = bfhi(kv.w);
        *(f32x4*)(dk + 8 * lane) = a; *(f32x4*)(dk + 8 * lane + 4) = b;
        a[0] = bflo(vv.x); a[1] = bfhi(vv.x); a[2] = bflo(vv.y); a[3] = bfhi(vv.y); b[0] = bflo(vv.z); b[1] = bfhi(vv.z); b[2] = bflo(vv.w); b[3] = bfhi(vv.w);
        *(f32x4*)(dv + 8 * lane) = a; *(f32x4*)(dv + 8 * lane + 4) = b;
    }
    for (int it = gw; it < 96 + 48; it += NGW) {
        size_t srow; float* d;
        if (it < 96) { const int b = it / 3, j = it % 3; srow = (size_t)b * 2048 + 2045 + j; d = out + O_PBC + (size_t)it * 1536; }
        else { const int r = it - 96, b = r / 3, j = r % 3; srow = (size_t)MP + b * 16 + 13 + j; d = out + O_SBC + (size_t)r * 1536; }
        const bf16_t* sp = proj + srow * NPJ + 1536;
        for (int c = lane; c < 1536; c += 64) d[c] = bf2f(sp[c]);
    }
}

constexpr int DN_Q = 0, DN_K = 17408, DN_KT = 34816, DN_ST = 53248, DN_IN = 88064, DN_L = 97280, DN_U = 113664, DN_VW = 130048, DN_VEC = 148480;
DI void dn_prompt(const Prm& p, unsigned char* lds, int tid0, int wave0, int lane0, int b, int h, bool dry) {
    int tid = tid0, wave = wave0, lane = lane0;
    bf16_t* proj = (bf16_t*)(p.ws + WS_BIG); const float* bd = (const float*)(p.ws + WS_BD);
    int r32 = lane & 31, hi = lane >> 5;
    float* vec = (float*)(lds + DN_VEC);
    float cw[3][4][2];
#pragma unroll
    for (int pt = 0; pt < 3; ++pt)
#pragma unroll
        for (int j = 0; j < 4; ++j) { const float* w = p.in[16] + (size_t)j * 1536 + pt * 512 + h * 128 + 2 * lane; cw[pt][j][0] = w[0]; cw[pt][j][1] = w[1]; }
    const float gn0 = p.in[19][2 * lane], gn1 = p.in[19][2 * lane + 1];
    for (int i = tid; i < 34816 / 4; i += NT) ((unsigned*)(lds + DN_ST))[i] = 0u;
    f32x16 S0, S1;
#pragma unroll
    for (int i = 0; i < 16; ++i) { S0[i] = 0.f; S1[i] = 0.f; }
    __syncthreads();
    for (int n = 0; n < 32; ++n) {
        int zz = 0; asm volatile("" : "+s"(zz)); unsigned char* LB = lds + zz; float* VEC = (float*)(LB + DN_VEC);
#define RELAUNDER() do { asm volatile("" : "+s"(zz), "+s"(wave), "+v"(lane)); LB = lds + zz; VEC = (float*)(LB + DN_VEC); r32 = lane & 31; hi = lane >> 5; tid = wave * 64 + lane; } while (0)
        const size_t rowc = (size_t)b * 2048 + n * 64;
        const float g_t = bd[(rowc + lane) * 8 + 4 + h], be_t = bd[(rowc + lane) * 8 + h];
        unsigned zq[8], xraw[3][11];
#pragma unroll
        for (int i = 0; i < 11; ++i) { const long tt = (long)n * 64 + wave * 8 + i - 3;
#pragma unroll
            for (int pt = 0; pt < 3; ++pt) { unsigned u = 0u; if (tt >= 0) u = *(const unsigned*)(proj + ((size_t)b * 2048 + tt) * NPJ + 1536 + pt * 512 + h * 128 + 2 * lane); xraw[pt][i] = u; } }
#pragma unroll
        for (int i = 0; i < 8; ++i) zq[i] = *(const unsigned*)(proj + (rowc + wave * 8 + i) * NPJ + 3072 + h * 128 + 2 * lane);
        float gc = g_t;
#pragma unroll
        for (int o = 1; o < 64; o <<= 1) { const float t = __shfl_up(gc, o); if (lane >= o) gc += t; }
        const float gl = __shfl(gc, 63);
        const float kdsc = __expf(gl - gc);
        if (wave == 0) { VEC[lane] = gc; VEC[64 + lane] = __expf(gc); VEC[128 + lane] = be_t; }
        RELAUNDER();
        {
            float xr[3][11][2];
#pragma unroll
            for (int i = 0; i < 11; ++i)
#pragma unroll
                for (int pt = 0; pt < 3; ++pt) { xr[pt][i][0] = bflo(xraw[pt][i]); xr[pt][i][1] = bfhi(xraw[pt][i]); }
            unsigned kt0[4], kt1[4];
#pragma unroll
            for (int i = 0; i < 8; ++i) {
                const int t = wave * 8 + i;
                float y[3][2];
#pragma unroll
                for (int pt = 0; pt < 3; ++pt)
#pragma unroll
                    for (int e = 0; e < 2; ++e) { const float a = (xr[pt][i][e] * cw[pt][0][e] + xr[pt][i + 1][e] * cw[pt][1][e]) + (xr[pt][i + 2][e] * cw[pt][2][e] + xr[pt][i + 3][e] * cw[pt][3][e]); y[pt][e] = silu_f(a); }
                const float sq = wave_sum(y[0][0] * y[0][0] + y[0][1] * y[0][1]), sk = wave_sum(y[1][0] * y[1][0] + y[1][1] * y[1][1]);
                const float rq = rsqrtf(sq + 1e-6f) * 0.08838834764831845f, rk = rsqrtf(sk + 1e-6f);
                const float q0 = y[0][0] * rq, q1 = y[0][1] * rq, k0 = y[1][0] * rk, k1 = y[1][1] * rk;
                *(unsigned*)(LB + DN_Q + t * 272 + 4 * lane) = cvt_pk_bf16(q0, q1);
                *(unsigned*)(LB + DN_K + t * 272 + 4 * lane) = cvt_pk_bf16(k0, k1);
                *(unsigned*)(LB + DN_VW + t * 256 + 4 * lane) = cvt_pk_bf16(y[2][0], y[2][1]);
                const float ds = __shfl(kdsc, t);
                const unsigned pk = cvt_pk_bf16(k0 * ds, k1 * ds);
                if ((i & 1) == 0) { kt0[i >> 1] = pk & 0xffffu; kt1[i >> 1] = pk >> 16; } else { kt0[i >> 1] |= pk << 16; kt1[i >> 1] |= pk & 0xffff0000u; }
            }
            u32x4 w0, w1; w0.x = kt0[0]; w0.y = kt0[1]; w0.z = kt0[2]; w0.w = kt0[3]; w1.x = kt1[0]; w1.y = kt1[1]; w1.z = kt1[2]; w1.w = kt1[3];
            *(u32x4*)(LB + DN_KT + (2 * lane) * 144 + 16 * wave) = w0;
            *(u32x4*)(LB + DN_KT + (2 * lane + 1) * 144 + 16 * wave) = w1;
        }
        __syncthreads();
        RELAUNDER();
        {
            const int which = wave >> 2, ib = (wave >> 1) & 1, jb = wave & 1;
            f32x16 c;
#pragma unroll
            for (int i = 0; i < 16; ++i) c[i] = 0.f;
            const unsigned char* ab = LB + (which ? DN_Q : DN_K) + (32 * ib + r32) * 272 + 16 * hi;
            const unsigned char* bb = LB + DN_K + (32 * jb + r32) * 272 + 16 * hi;
#pragma unroll
            for (int s = 0; s < 8; ++s) c = MFMA32(*(const bf16x8*)(ab + 32 * s), *(const bf16x8*)(bb + 32 * s), c);
            const int j = 32 * jb + r32; const float gcj = VEC[j];
#pragma unroll
            for (int r = 0; r < 16; ++r) {
                const int i = 32 * ib + crow(r, hi); const float gci = VEC[i];
                if (which == 0) { const float v = (j < i) ? c[r] * VEC[128 + i] * __expf(gci - gcj) : 0.f; *(float*)(LB + DN_L + i * 256 + j * 4) = v; }
                else { const float v = (j <= i) ? c[r] * __expf(gci - gcj) : 0.f; *(bf16_t*)(LB + DN_IN + i * 144 + j * 2) = (bf16_t)(cvt_pk_bf16(v, 0.f) & 0xffffu); }
            }
        }
        __syncthreads();
        RELAUNDER();
        {
            float x[64];
            int oL = DN_L, oV = DN_VEC; asm volatile("" : "+v"(oL), "+v"(oV));
            const float* vecl = (const float*)(LB + oV);
            if (tid < 128) {
                int oS = DN_VW + 2 * tid; asm volatile("" : "+v"(oS));
#pragma unroll
                for (int i = 0; i < 64; ++i) { x[i] = vecl[128 + i] * bf2f(*(const bf16_t*)(LB + oS + i * 256)); if ((i & 7) == 7) __builtin_amdgcn_sched_barrier(0); }
            } else if (tid < 256) {
                int oS = DN_K + 2 * (tid - 128); asm volatile("" : "+v"(oS));
#pragma unroll
                for (int i = 0; i < 64; ++i) { x[i] = vecl[128 + i] * vecl[64 + i] * bf2f(*(const bf16_t*)(LB + oS + i * 272)); if ((i & 7) == 7) __builtin_amdgcn_sched_barrier(0); }
            }
            __syncthreads();
            if (tid < 256) {
#pragma unroll
                for (int sidx = 0; sidx < 16; ++sidx) {
                    const int j0 = 4 * sidx;
                    { const f32x4 l1 = *(const f32x4*)(lds + oL + (j0 + 1) * 256 + j0 * 4), l2 = *(const f32x4*)(lds + oL + (j0 + 2) * 256 + j0 * 4), l3 = *(const f32x4*)(lds + oL + (j0 + 3) * 256 + j0 * 4);
                      x[j0 + 1] -= l1[0] * x[j0];
                      x[j0 + 2] -= l2[0] * x[j0]; x[j0 + 2] -= l2[1] * x[j0 + 1];
                      x[j0 + 3] -= l3[0] * x[j0]; x[j0 + 3] -= l3[1] * x[j0 + 1]; x[j0 + 3] -= l3[2] * x[j0 + 2]; }
#pragma unroll
                    for (int i0 = j0 + 4; i0 < 64; i0 += 12) {
                        f32x4 lb[12];
#pragma unroll
                        for (int e = 0; e < 12; ++e) if (i0 + e < 64) lb[e] = *(const f32x4*)(lds + oL + (i0 + e) * 256 + j0 * 4);
                        __builtin_amdgcn_sched_barrier(0);
#pragma unroll
                        for (int e = 0; e < 12; ++e) if (i0 + e < 64) { const int i = i0 + e;
                            x[i] -= lb[e][0] * x[j0]; x[i] -= lb[e][1] * x[j0 + 1]; x[i] -= lb[e][2] * x[j0 + 2]; x[i] -= lb[e][3] * x[j0 + 3]; }
                        __builtin_amdgcn_sched_barrier(0);
                    }
                }
                if (tid < 128) {
                    int oD = DN_U + 2 * tid; asm volatile("" : "+v"(oD));
#pragma unroll
                    for (int i = 0; i < 64; ++i) *(bf16_t*)(LB + oD + i * 256) = (bf16_t)(cvt_pk_bf16(x[i], 0.f) & 0xffffu);
                } else {
                    int oD = DN_VW + 2 * (tid - 128); asm volatile("" : "+v"(oD));
#pragma unroll
                    for (int i = 0; i < 64; ++i) *(bf16_t*)(LB + oD + i * 272) = (bf16_t)(cvt_pk_bf16(x[i], 0.f) & 0xffffu);
                }
            }
        }
        __syncthreads();
        const int tb = wave >> 2, dvb = wave & 3;
        const int dvl = 32 * dvb + r32;
        RELAUNDER();
        {
            f32x16 c;
#pragma unroll
            for (int i = 0; i < 16; ++i) c[i] = 0.f;
            const unsigned char* ab = LB + DN_VW + (32 * tb + r32) * 272 + 16 * hi;
            const unsigned char* bb = LB + DN_ST + dvl * 272 + 16 * hi;
#pragma unroll
            for (int s = 0; s < 8; ++s) c = MFMA32(*(const bf16x8*)(ab + 32 * s), *(const bf16x8*)(bb + 32 * s), c);
#pragma unroll
            for (int r = 0; r < 16; ++r) c[r] = bf2f(*(const bf16_t*)(LB + DN_U + (32 * tb + crow(r, hi)) * 256 + 2 * dvl)) - c[r];
            __syncthreads();
#pragma unroll
            for (int g = 0; g < 4; ++g) { u32x2 w; w.x = cvt_pk_bf16(c[4 * g], c[4 * g + 1]); w.y = cvt_pk_bf16(c[4 * g + 2], c[4 * g + 3]);
                *(u32x2*)(LB + DN_VW + dvl * 144 + (32 * tb + 8 * g + 4 * hi) * 2) = w; }
        }
        __syncthreads();
        RELAUNDER();
        {
            f32x16 c;
#pragma unroll
            for (int i = 0; i < 16; ++i) c[i] = 0.f;
            const unsigned char* ab = LB + DN_Q + (32 * tb + r32) * 272 + 16 * hi;
            const unsigned char* bb = LB + DN_ST + dvl * 272 + 16 * hi;
#pragma unroll
            for (int s = 0; s < 8; ++s) c = MFMA32(*(const bf16x8*)(ab + 32 * s), *(const bf16x8*)(bb + 32 * s), c);
#pragma unroll
            for (int r = 0; r < 16; ++r) c[r] *= VEC[64 + 32 * tb + crow(r, hi)];
            const unsigned char* ib_ = LB + DN_IN + (32 * tb + r32) * 144 + 16 * hi;
            const unsigned char* vb_ = LB + DN_VW + dvl * 144 + 16 * hi;
#pragma unroll
            for (int s = 0; s < 4; ++s) c = MFMA32(*(const bf16x8*)(ib_ + 32 * s), *(const bf16x8*)(vb_ + 32 * s), c);
#pragma unroll
            for (int r = 0; r < 16; ++r) *(float*)(LB + DN_L + ((32 * tb + crow(r, hi)) * 128 + dvl) * 4) = c[r];
            const int dkb = wave >> 1, dv0 = (wave & 1) * 64;
            const float egl = __expf(gl);
            const unsigned char* ka = LB + DN_KT + (32 * dkb + r32) * 144 + 16 * hi;
            const unsigned char* v0 = LB + DN_VW + (dv0 + r32) * 144 + 16 * hi;
            const unsigned char* v1 = LB + DN_VW + (dv0 + 32 + r32) * 144 + 16 * hi;
#pragma unroll
            for (int i = 0; i < 16; ++i) { S0[i] *= egl; S1[i] *= egl; }
#pragma unroll
            for (int s = 0; s < 4; ++s) { const bf16x8 a = *(const bf16x8*)(ka + 32 * s); S0 = MFMA32(a, *(const bf16x8*)(v0 + 32 * s), S0); S1 = MFMA32(a, *(const bf16x8*)(v1 + 32 * s), S1); }
        }
        __syncthreads();
        {
        RELAUNDER();
            const int dkb = wave >> 1, dv0 = (wave & 1) * 64;
            asm volatile("s_nop 15\n\ts_nop 7" : "+v"(S0), "+v"(S1));
#pragma unroll
            for (int g = 0; g < 4; ++g) {
                u32x2 w; w.x = cvt_pk_bf16(S0[4 * g], S0[4 * g + 1]); w.y = cvt_pk_bf16(S0[4 * g + 2], S0[4 * g + 3]);
                *(u32x2*)(LB + DN_ST + (dv0 + r32) * 272 + (32 * dkb + 8 * g + 4 * hi) * 2) = w;
                w.x = cvt_pk_bf16(S1[4 * g], S1[4 * g + 1]); w.y = cvt_pk_bf16(S1[4 * g + 2], S1[4 * g + 3]);
                *(u32x2*)(LB + DN_ST + (dv0 + 32 + r32) * 272 + (32 * dkb + 8 * g + 4 * hi) * 2) = w;
            }
#pragma unroll
            for (int i = 0; i < 8; ++i) {
                const int t = wave * 8 + i;
                const float o0 = *(const float*)(LB + DN_L + (t * 128 + 2 * lane) * 4), o1 = *(const float*)(LB + DN_L + (t * 128 + 2 * lane + 1) * 4);
                const float ssq = wave_sum(o0 * o0 + o1 * o1);
                const float rs = rsqrtf(ssq * (1.0f / 128.0f) + 1e-6f);
                const unsigned zu = zq[i];
                unsigned* zp = (unsigned*)(proj + (rowc + t) * NPJ + 3072 + h * 128 + 2 * lane);
                unsigned* zo = dry ? (unsigned*)((bf16_t*)(p.ws + WS_XB) + (rowc + t) * 1024 + 512 + h * 128 + 2 * lane) : zp;
                *zo = cvt_pk_bf16(o0 * rs * gn0 * silu_f(bflo(zu)), o1 * rs * gn1 * silu_f(bfhi(zu)));
            }
        }
    }
#undef RELAUNDER
    {
        float* so = p.out + O_PBS + ((size_t)(b * 4 + h)) * 16384;
        const int dkb = wave >> 1, dv0 = (wave & 1) * 64;
#pragma unroll
        for (int r = 0; r < 16; ++r) { const int dk = 32 * dkb + crow(r, hi); so[dk * 128 + dv0 + r32] = S0[r]; so[dk * 128 + dv0 + 32 + r32] = S1[r]; }
    }
    __syncthreads();
}

DI void dn_sample(const Prm& p, unsigned char* lds, int tid, int wave, int lane, int b, int h, bool dry) {
    bf16_t* proj = (bf16_t*)(p.ws + WS_BIG); const float* bd = (const float*)(p.ws + WS_BD);
    float* qkv = (float*)lds;
    float* red = (float*)(lds + 24576);
    float* ost = (float*)(lds + 24576 + 4096);
    const size_t row0 = (size_t)MP + b * 16;
    for (int idx = tid; idx < 6144; idx += NT) {
        const int t = idx / 384, ch = idx % 384, pt = ch >> 7, cc = ch & 127, pc = pt * 512 + h * 128 + cc;
        float a = 0.f;
#pragma unroll
        for (int j = 0; j < 4; ++j) { const int m = t + j;
            const float xv = m < 3 ? p.in[4][((size_t)b * 3 + m) * 1536 + pc] : bf2f(proj[(row0 + m - 3) * NPJ + 1536 + pc]);
            a += xv * p.in[16][(size_t)j * 1536 + pc]; }
        qkv[(pt * 16 + t) * 128 + cc] = silu_f(a);
    }
    __syncthreads();
    for (int rr = wave; rr < 32; rr += 8) {
        float* r = qkv + rr * 128; const float a = r[2 * lane], c = r[2 * lane + 1];
        const float s = wave_sum(a * a + c * c); const float sc = rsqrtf(s + 1e-6f) * (rr < 16 ? 0.08838834764831845f : 1.0f);
        r[2 * lane] = a * sc; r[2 * lane + 1] = c * sc;
    }
    __syncthreads();
    const int c = tid & 127, qd = tid >> 7;
    float S[32];
    const float* s0 = p.in[5] + ((size_t)(b * 4 + h)) * 16384;
#pragma unroll
    for (int i = 0; i < 32; ++i) S[i] = s0[(qd * 32 + i) * 128 + c];
    for (int t = 0; t < 16; ++t) {
        const float* qv = qkv + t * 128 + qd * 32; const float* kv = qkv + (16 + t) * 128 + qd * 32; const float vv = qkv[(32 + t) * 128 + c];
        const float be = bd[(row0 + t) * 8 + h], a = __expf(bd[(row0 + t) * 8 + 4 + h]);
        float pk = 0.f;
#pragma unroll
        for (int i = 0; i < 32; ++i) pk += kv[i] * S[i];
        red[qd * 128 + c] = pk;
        __syncthreads();
        const float ks = (red[c] + red[128 + c]) + (red[256 + c] + red[384 + c]);
        const float coef = be * (vv - a * ks);
        float po = 0.f;
#pragma unroll
        for (int i = 0; i < 32; ++i) { S[i] = a * S[i] + kv[i] * coef; po += qv[i] * S[i]; }
        red[512 + qd * 128 + c] = po;
        __syncthreads();
        if (qd == 0) ost[t * 128 + c] = (red[512 + c] + red[640 + c]) + (red[768 + c] + red[896 + c]);
    }
    float* so = p.out + O_SBS + ((size_t)(b * 4 + h)) * 16384;
#pragma unroll
    for (int i = 0; i < 32; ++i) so[(qd * 32 + i) * 128 + c] = S[i];
    __syncthreads();
    for (int t = wave; t < 16; t += 8) {
        const float o0 = ost[t * 128 + 2 * lane], o1 = ost[t * 128 + 2 * lane + 1];
        const float rs = rsqrtf(wave_sum(o0 * o0 + o1 * o1) * (1.0f / 128.0f) + 1e-6f);
        unsigned* zp = (unsigned*)(proj + (row0 + t) * NPJ + 3072 + h * 128 + 2 * lane);
        const unsigned zu = *zp;
        unsigned* zo = dry ? (unsigned*)((bf16_t*)(p.ws + WS_XB) + (row0 + t) * 1024 + 512 + h * 128 + 2 * lane) : zp;
        *zo = cvt_pk_bf16(o0 * rs * p.in[19][2 * lane] * silu_f(bflo(zu)), o1 * rs * p.in[19][2 * lane + 1] * silu_f(bfhi(zu)));
    }
    __syncthreads();
}

constexpr int AT_BIAS = 131072;
constexpr float LOG2E = 1.4426950408889634f;
DI void attn_unit(const Prm& p, unsigned char* lds, int wave, int lane, int u, bool dry) {
    bf16_t* proj = (bf16_t*)(p.ws + WS_BIG);
    const int r32 = lane & 31, hi = lane >> 5;
    const int half = u & 1, h = (u >> 1) & 7, c = (u >> 4) & 31, b = u >> 9;
    unsigned char* vt = lds + wave * 16384;
    const float* bias = (const float*)(lds + AT_BIAS) + h * 257;
    const size_t qrow = (size_t)b * 2048 + c * 64 + half * 32 + r32;
    bf16x8 qf[4];
#pragma unroll
    for (int d0 = 0; d0 < 4; ++d0) qf[d0] = *(const bf16x8*)(proj + qrow * NPJ + h * 64 + 16 * d0 + 8 * hi);
    f32x16 o0, o1;
#pragma unroll
    for (int i = 0; i < 16; ++i) { o0[i] = 0.f; o1[i] = 0.f; }
    float mrun = -1e30f, lrun = 0.f;
    const float cbias = bias[256];
    const int qpos = half * 32 + r32;
    const float sc = 0.125f * LOG2E;
    const int jfirst = (c < 8 ? 8 - c : 0);
    bf16x8 kf[8];
    { const bf16_t* kp0 = proj + ((size_t)b * 2048 + (size_t)(c - 8 + jfirst) * 64 + r32) * NPJ + 512 + h * 64 + 8 * hi;
#pragma unroll
      for (int d0 = 0; d0 < 4; ++d0) { kf[2 * d0] = *(const bf16x8*)(kp0 + 16 * d0); kf[2 * d0 + 1] = *(const bf16x8*)(kp0 + (size_t)32 * NPJ + 16 * d0); } }
    for (int j = jfirst; j < 9; ++j) {
        const size_t krow0 = (size_t)b * 2048 + (size_t)(c - 8 + j) * 64;
        u32x4 va[4], vb[4];
#pragma unroll
        for (int i = 0; i < 4; ++i) { const int pair = lane & 31, ch = (lane >> 5) + 2 * i;
            const bf16_t* vp = proj + (krow0 + 2 * pair) * NPJ + 1024 + h * 64 + 8 * ch;
            va[i] = *(const u32x4*)vp; vb[i] = *(const u32x4*)(vp + NPJ); }
        f32x16 p0, p1;
#pragma unroll
        for (int i = 0; i < 16; ++i) { p0[i] = 0.f; p1[i] = 0.f; }
        bf16x8 kn[8];
        if (j + 1 < 9) { const bf16_t* kpn = proj + (krow0 + 64 + r32) * NPJ + 512 + h * 64 + 8 * hi;
#pragma unroll
            for (int d0 = 0; d0 < 4; ++d0) { kn[2 * d0] = *(const bf16x8*)(kpn + 16 * d0); kn[2 * d0 + 1] = *(const bf16x8*)(kpn + (size_t)32 * NPJ + 16 * d0); } }
        else {
#pragma unroll
            for (int d0 = 0; d0 < 8; ++d0) kn[d0] = kf[d0]; }
#pragma unroll
        for (int d0 = 0; d0 < 4; ++d0) { p0 = MFMA32(kf[2 * d0], qf[d0], p0); p1 = MFMA32(kf[2 * d0 + 1], qf[d0], p1); }
        if (j <= 5) {
#pragma unroll
            for (int r = 0; r < 16; ++r) { p0[r] = p0[r] * sc + cbias; p1[r] = p1[r] * sc + cbias; }
        } else {
            const int kb0 = (j - 8) * 64;
#pragma unroll
            for (int r = 0; r < 16; ++r) {
                int d = qpos - (kb0 + crow(r, hi)); int d1 = d - 32;
                d = d < -128 ? -128 : (d > 128 ? 128 : d); d1 = d1 < -128 ? -128 : (d1 > 128 ? 128 : d1);
                p0[r] = p0[r] * sc + bias[d + 128]; p1[r] = p1[r] * sc + bias[d1 + 128];
            }
        }
        float mt = p0[0];
#pragma unroll
        for (int r = 0; r < 16; ++r) { mt = fmaxf(mt, p0[r]); mt = fmaxf(mt, p1[r]); }
        mt = fmaxf(mt, __shfl_xor(mt, 32));
        const float mn = fmaxf(mrun, mt), alpha = exp2f(mrun - mn);
        mrun = mn;
        float ls = 0.f;
#pragma unroll
        for (int r = 0; r < 16; ++r) { p0[r] = exp2f(p0[r] - mn); p1[r] = exp2f(p1[r] - mn); ls += p0[r] + p1[r]; }
        lrun = lrun * alpha + ls;
#pragma unroll
        for (int r = 0; r < 16; ++r) { o0[r] *= alpha; o1[r] *= alpha; }
#pragma unroll
        for (int i = 0; i < 4; ++i) { const int pair = lane & 31, ch = (lane >> 5) + 2 * i; const int key = 2 * pair, pos = 16 * (key >> 4) + kslot(key & 15);
            unsigned char* wp = vt + (8 * ch) * 144 + pos * 2;
            const unsigned a0 = va[i].x, a1 = va[i].y, a2 = va[i].z, a3 = va[i].w, b0 = vb[i].x, b1 = vb[i].y, b2 = vb[i].z, b3 = vb[i].w;
            *(unsigned*)(wp + 0 * 144) = (a0 & 0xffffu) | (b0 << 16); *(unsigned*)(wp + 1 * 144) = (a0 >> 16) | (b0 & 0xffff0000u);
            *(unsigned*)(wp + 2 * 144) = (a1 & 0xffffu) | (b1 << 16); *(unsigned*)(wp + 3 * 144) = (a1 >> 16) | (b1 & 0xffff0000u);
            *(unsigned*)(wp + 4 * 144) = (a2 & 0xffffu) | (b2 << 16); *(unsigned*)(wp + 5 * 144) = (a2 >> 16) | (b2 & 0xffff0000u);
            *(unsigned*)(wp + 6 * 144) = (a3 & 0xffffu) | (b3 << 16); *(unsigned*)(wp + 7 * 144) = (a3 >> 16) | (b3 & 0xffff0000u); }
        __builtin_amdgcn_wave_barrier(); asm volatile("s_waitcnt lgkmcnt(0)" ::: "memory");
        const unsigned char* vr = vt + r32 * 144 + 16 * hi;
#pragma unroll
        for (int kb4 = 0; kb4 < 4; ++kb4) {
            const bf16x8 pf = (kb4 < 2) ? pack8(p0, kb4 & 1) : pack8(p1, kb4 & 1);
            o0 = MFMA32(*(const bf16x8*)(vr + 32 * kb4), pf, o0);
            o1 = MFMA32(*(const bf16x8*)(vr + 32 * 144 + 32 * kb4), pf, o1);
        }
        __builtin_amdgcn_wave_barrier(); asm volatile("s_waitcnt lgkmcnt(0)" ::: "memory");
#pragma unroll
        for (int d0 = 0; d0 < 8; ++d0) kf[d0] = kn[d0];
    }
    lrun += __shfl_xor(lrun, 32);
    const float inv = 1.0f / lrun;
    bf16_t* op = dry ? (bf16_t*)(p.ws + WS_XB) + qrow * 1024 + h * 64 : proj + qrow * NPJ + h * 64;
#pragma unroll
    for (int g = 0; g < 4; ++g) {
        u32x2 w; w.x = cvt_pk_bf16(o0[4 * g] * inv, o0[4 * g + 1] * inv); w.y = cvt_pk_bf16(o0[4 * g + 2] * inv, o0[4 * g + 3] * inv);
        *(u32x2*)(op + 8 * g + 4 * hi) = w;
        w.x = cvt_pk_bf16(o1[4 * g] * inv, o1[4 * g + 1] * inv); w.y = cvt_pk_bf16(o1[4 * g + 2] * inv, o1[4 * g + 3] * inv);
        *(u32x2*)(op + 32 + 8 * g + 4 * hi) = w;
    }
}

DI void attn_sample(const Prm& p, unsigned char* lds, int tid, int wave, int lane, int b, int h, bool dry) {
    bf16_t* proj = (bf16_t*)(p.ws + WS_BIG);
    float* qs = (float*)lds;
    float* S = (float*)(lds + 4096);
    const float* biasg = p.in[15] + h * 257;
    const size_t row0 = (size_t)MP + b * 16;
    __syncthreads();
    for (int idx = tid; idx < 1024; idx += NT) { const int t = idx >> 6, d = idx & 63; qs[idx] = bf2f(proj[(row0 + t) * NPJ + h * 64 + d]); }
    __syncthreads();
    for (int kk = tid; kk < 528; kk += NT) {
        float kr[64];
        if (kk < 512) { const f32x4* kp = (const f32x4*)(p.in[2] + (((size_t)b * 512 + kk) * 8 + h) * 64);
#pragma unroll
            for (int i = 0; i < 16; ++i) { const f32x4 v = kp[i]; kr[4 * i] = v[0]; kr[4 * i + 1] = v[1]; kr[4 * i + 2] = v[2]; kr[4 * i + 3] = v[3]; } }
        else { const bf16_t* kp = proj + (row0 + kk - 512) * NPJ + 512 + h * 64;
#pragma unroll
            for (int i = 0; i < 64; ++i) kr[i] = bf2f(kp[i]); }
        const int kpos = kk - 512;
        for (int t = 0; t < 16; ++t) {
            float a = 0.f;
#pragma unroll
            for (int i = 0; i < 64; ++i) a += qs[t * 64 + i] * kr[i];
            int d = t - kpos; d = d < -128 ? -128 : (d > 128 ? 128 : d);
            S[t * 528 + kk] = a * 0.125f + biasg[d + 128];
        }
    }
    __syncthreads();
    for (int t = wave; t < 16; t += 8) {
        float m = -1e30f;
        for (int kk = lane; kk < 528; kk += 64) m = fmaxf(m, S[t * 528 + kk]);
#pragma unroll
        for (int o = 1; o < 64; o <<= 1) m = fmaxf(m, __shfl_xor(m, o));
        float s = 0.f;
        for (int kk = lane; kk < 528; kk += 64) { const float e = __expf(S[t * 528 + kk] - m); S[t * 528 + kk] = e; s += e; }
        s = wave_sum(s); const float inv = 1.0f / s;
        for (int kk = lane; kk < 528; kk += 64) S[t * 528 + kk] *= inv;
    }
    __syncthreads();
    {
        const int d = tid & 63, t0 = (tid >> 6) * 2;
        float a0 = 0.f, a1 = 0.f;
        for (int kk = 0; kk < 528; ++kk) {
            const float v = kk < 512 ? p.in[3][(((size_t)b * 512 + kk) * 8 + h) * 64 + d] : bf2f(proj[(row0 + kk - 512) * NPJ + 1024 + h * 64 + d]);
            a0 += S[t0 * 528 + kk] * v; a1 += S[(t0 + 1) * 528 + kk] * v;
        }
        bf16_t* ob_ = dry ? (bf16_t*)(p.ws + WS_XB) + (row0 + t0) * 1024 + h * 64 + d : proj + (row0 + t0) * NPJ + h * 64 + d;
        ob_[0] = (bf16_t)(cvt_pk_bf16(a0, 0.f) & 0xffffu);
        ob_[dry ? 1024 : NPJ] = (bf16_t)(cvt_pk_bf16(a1, 0.f) & 0xffffu);
    }
    __syncthreads();
}

DI void xattn_stage_v(const bf16_t* memv, unsigned char* lds, int tid, size_t kvrow0, int h) {
    __syncthreads();
#pragma unroll 2
    for (int i = 0; i < 8; ++i) { const int item = tid + NT * i, pair = item & 127, ch = item >> 7;
        const bf16_t* vp = memv + (kvrow0 + 2 * pair) * DM + h * 256 + 8 * ch;
        const u32x4 a = *(const u32x4*)vp, bq = *(const u32x4*)(vp + DM);
        const int key = 2 * pair, pos = 16 * (key >> 4) + kslot(key & 15);
        unsigned char* wp = lds + (8 * ch) * 528 + pos * 2;
        *(unsigned*)(wp + 0 * 528) = (a.x & 0xffffu) | (bq.x << 16); *(unsigned*)(wp + 1 * 528) = (a.x >> 16) | (bq.x & 0xffff0000u);
        *(unsigned*)(wp + 2 * 528) = (a.y & 0xffffu) | (bq.y << 16); *(unsigned*)(wp + 3 * 528) = (a.y >> 16) | (bq.y & 0xffff0000u);
        *(unsigned*)(wp + 4 * 528) = (a.z & 0xffffu) | (bq.z << 16); *(unsigned*)(wp + 5 * 528) = (a.z >> 16) | (bq.z & 0xffff0000u);
        *(unsigned*)(wp + 6 * 528) = (a.w & 0xffffu) | (bq.w << 16); *(unsigned*)(wp + 7 * 528) = (a.w >> 16) | (bq.w & 0xffff0000u); }
    __syncthreads();
}
constexpr int XK_OFF = 135168;
#define XBAR() do { asm volatile("s_waitcnt lgkmcnt(0)" ::: "memory"); __builtin_amdgcn_s_barrier(); asm volatile("" ::: "memory"); } while (0)
DI void xattn_unit_k(const bf16_t* qx, const bf16_t* memk, bf16_t* ox, unsigned char* lds, int tid, int lane, size_t qrow0, size_t kvrow0, int h, int nvalid, int dh) {
    const int r32 = lane & 31, hi = lane >> 5;
    f32x16 o[4];
#pragma unroll
    for (int d = 0; d < 4; ++d)
#pragma unroll
        for (int i = 0; i < 16; ++i) o[d][i] = 0.f;
    float mrun = -1e30f, lrun = 0.f;
    const bf16_t* qp = qx + (qrow0 + r32) * DM + h * 256 + 8 * hi;
    const int kkey = tid >> 5, kc16 = tid & 31;
    const bf16_t* kg = memk + (kvrow0 + kkey) * DM + h * 256 + 8 * kc16;
    unsigned char* kl = lds + XK_OFF + kkey * 528 + kc16 * 16;
    u32x4 kr0 = *(const u32x4*)kg, kr1 = *(const u32x4*)(kg + (size_t)16 * DM);
    bf16x8 qf[16];
#pragma unroll
    for (int s = 0; s < 16; ++s) qf[s] = *(const bf16x8*)(qp + 16 * s);
    for (int kt = 0; kt < 4; ++kt) {
        f32x16 p0, p1;
#pragma unroll
        for (int i = 0; i < 16; ++i) { p0[i] = 0.f; p1[i] = 0.f; }
#pragma unroll
        for (int hf = 0; hf < 2; ++hf) {
            XBAR();
            *(u32x4*)kl = kr0; *(u32x4*)(kl + 16 * 528) = kr1;
            { const int nh = 2 * kt + hf + 1;
              if (nh < 8) { const bf16_t* g2 = kg + (size_t)(32 * nh) * DM; kr0 = *(const u32x4*)g2; kr1 = *(const u32x4*)(g2 + (size_t)16 * DM); } }
            XBAR();
            const unsigned char* kb = lds + XK_OFF + r32 * 528 + 16 * hi;
            if (hf == 0) {
#pragma unroll
                for (int sb = 0; sb < 2; ++sb) { bf16x8 kfr[8];
#pragma unroll
                    for (int s = 0; s < 8; ++s) kfr[s] = *(const bf16x8*)(kb + 32 * (8 * sb + s));
                    __builtin_amdgcn_sched_barrier(0);
#pragma unroll
                    for (int s = 0; s < 8; ++s) p0 = MFMA32(kfr[s], qf[8 * sb + s], p0);
                    __builtin_amdgcn_sched_barrier(0); }
            } else {
#pragma unroll
                for (int sb = 0; sb < 2; ++sb) { bf16x8 kfr[8];
#pragma unroll
                    for (int s = 0; s < 8; ++s) kfr[s] = *(const bf16x8*)(kb + 32 * (8 * sb + s));
                    __builtin_amdgcn_sched_barrier(0);
#pragma unroll
                    for (int s = 0; s < 8; ++s) p1 = MFMA32(kfr[s], qf[8 * sb + s], p1);
                    __builtin_amdgcn_sched_barrier(0); }
            }
        }
        float mt = p0[0];
#pragma unroll
        for (int r = 0; r < 16; ++r) { mt = fmaxf(mt, p0[r]); mt = fmaxf(mt, p1[r]); }
        mt = fmaxf(mt, __shfl_xor(mt, 32));
        const float mn = fmaxf(mrun, mt), alpha = exp2f(mrun - mn);
        mrun = mn;
        float ls = 0.f;
#pragma unroll
        for (int r = 0; r < 16; ++r) { p0[r] = exp2f(p0[r] - mn); p1[r] = exp2f(p1[r] - mn); ls += p0[r] + p1[r]; }
        lrun = lrun * alpha + ls;
#pragma unroll
        for (int d = 0; d < 4; ++d)
#pragma unroll
            for (int r = 0; r < 16; ++r) o[d][r] *= alpha;
        const unsigned char* vr = lds + (128 * dh + r32) * 528 + (64 * kt + 8 * hi) * 2;
#pragma unroll
        for (int kb4 = 0; kb4 < 4; ++kb4) {
            const bf16x8 pf = (kb4 < 2) ? pack8(p0, kb4 & 1) : pack8(p1, kb4 & 1); bf16x8 vfr[4];
#pragma unroll
            for (int d = 0; d < 4; ++d) vfr[d] = *(const bf16x8*)(vr + d * 32 * 528 + 32 * kb4);
            __builtin_amdgcn_sched_barrier(0);
#pragma unroll
            for (int d = 0; d < 4; ++d) o[d] = MFMA32(vfr[d], pf, o[d]);
        }
    }
    lrun += __shfl_xor(lrun, 32);
    const float inv = 1.0f / lrun;
    if (r32 < nvalid) {
        bf16_t* op = ox + (qrow0 + r32) * DM + h * 256 + 128 * dh;
#pragma unroll
        for (int d = 0; d < 4; ++d)
#pragma unroll
            for (int g = 0; g < 4; ++g) {
                u32x2 w; w.x = cvt_pk_bf16(o[d][4 * g] * inv, o[d][4 * g + 1] * inv); w.y = cvt_pk_bf16(o[d][4 * g + 2] * inv, o[d][4 * g + 3] * inv);
                *(u32x2*)(op + 32 * d + 8 * g + 4 * hi) = w;
            }
    }
    XBAR();
}
DI void xattn_wave(const bf16_t* qx, const bf16_t* memk, bf16_t* ox, const unsigned char* lds, int lane, size_t qrow0, size_t kvrow0, int h, int nvalid) {
    const int r32 = lane & 31, hi = lane >> 5;
    f32x16 o[8];
#pragma unroll
    for (int d = 0; d < 8; ++d)
#pragma unroll
        for (int i = 0; i < 16; ++i) o[d][i] = 0.f;
    float mrun = -1e30f, lrun = 0.f;
    const bf16_t* qp = qx + (qrow0 + r32) * DM + h * 256 + 8 * hi;
    for (int kt = 0; kt < 4; ++kt) {
        f32x16 p0, p1;
#pragma unroll
        for (int i = 0; i < 16; ++i) { p0[i] = 0.f; p1[i] = 0.f; }
        const bf16_t* kp = memk + (kvrow0 + 64 * kt + r32) * DM + h * 256 + 8 * hi;
#pragma unroll 4
        for (int s = 0; s < 16; ++s) { const bf16x8 q = *(const bf16x8*)(qp + 16 * s), k0 = *(const bf16x8*)(kp + 16 * s), k1 = *(const bf16x8*)(kp + (size_t)32 * DM + 16 * s);
            p0 = MFMA32(k0, q, p0); p1 = MFMA32(k1, q, p1); }
        float mt = p0[0];
#pragma unroll
        for (int r = 0; r < 16; ++r) { mt = fmaxf(mt, p0[r]); mt = fmaxf(mt, p1[r]); }
        mt = fmaxf(mt, __shfl_xor(mt, 32));
        const float mn = fmaxf(mrun, mt), alpha = exp2f(mrun - mn);
        mrun = mn;
        float ls = 0.f;
#pragma unroll
        for (int r = 0; r < 16; ++r) { p0[r] = exp2f(p0[r] - mn); p1[r] = exp2f(p1[r] - mn); ls += p0[r] + p1[r]; }
        lrun = lrun * alpha + ls;
#pragma unroll
        for (int d = 0; d < 8; ++d)
#pragma unroll
            for (int r = 0; r < 16; ++r) o[d][r] *= alpha;
        const unsigned char* vr = lds + r32 * 528 + (64 * kt + 8 * hi) * 2;
#pragma unroll
        for (int kb4 = 0; kb4 < 4; ++kb4) {
            const bf16x8 pf = (kb4 < 2) ? pack8(p0, kb4 & 1) : pack8(p1, kb4 & 1);
#pragma unroll
            for (int d = 0; d < 8; ++d) o[d] = MFMA32(*(const bf16x8*)(vr + d * 32 * 528 + 32 * kb4), pf, o[d]);
        }
    }
    lrun += __shfl_xor(lrun, 32);
    const float inv = 1.0f / lrun;
    if (r32 < nvalid) {
        bf16_t* op = ox + (qrow0 + r32) * DM + h * 256;
#pragma unroll
        for (int d = 0; d < 8; ++d)
#pragma unroll
            for (int g = 0; g < 4; ++g) {
                u32x2 w; w.x = cvt_pk_bf16(o[d][4 * g] * inv, o[d][4 * g + 1] * inv); w.y = cvt_pk_bf16(o[d][4 * g + 2] * inv, o[d][4 * g + 3] * inv);
                *(u32x2*)(op + 32 * d + 8 * g + 4 * hi) = w;
            }
    }
}

#define LAS __attribute__((address_space(3)))
#define XB_TMO      128
#define XB_XCNT(j)  (256  + 64 * (j))
#define XB_XSUB(j)  (1280 + 64 * (j))
#define XB_XGEN(j)  (2304 + 64 * (j))
#define XB_TOP      3328
#define XB_TOPGEN   3392
#define XCD_BAR_WORDS 3456
#define XB_SPIN_CAP (1u << 18)

__device__ __forceinline__ unsigned xb_ld(unsigned* p)              { return __hip_atomic_load(p, __ATOMIC_RELAXED, __HIP_MEMORY_SCOPE_AGENT); }
__device__ __forceinline__ unsigned xb_add(unsigned* p, unsigned v) { return __hip_atomic_fetch_add(p, v, __ATOMIC_RELAXED, __HIP_MEMORY_SCOPE_AGENT); }
__device__ __forceinline__ unsigned xb_xcc_id() { return (unsigned)__builtin_amdgcn_s_getreg((3 << 11) | 20) & 0xFu; }
#define XB_SPIN(cond, bar) do { unsigned _sp = 0; while (cond) { __builtin_amdgcn_s_sleep(1); \
    if ((++_sp & 255u) == 0u) { if (xb_ld(&(bar)[XB_TMO])) break; if (_sp > XB_SPIN_CAP) { atomicAdd(&(bar)[XB_TMO], 1u); break; } } } } while (0)

struct XcdBarrier {
    unsigned* bar; unsigned x;
    volatile LAS unsigned* st;
};

__device__ __forceinline__ XcdBarrier xcd_barrier_post(unsigned* bar, volatile LAS unsigned* st) {
    XcdBarrier b; b.bar = bar; b.x = xb_xcc_id(); b.st = st;
    if (threadIdx.x == 0) (void)xb_add(&bar[XB_XCNT(b.x)], 1u);
    return b;
}
__device__ __forceinline__ void xcd_barrier_complete(unsigned* bar, unsigned x, unsigned& nloc, unsigned& nx) {
    const unsigned G = gridDim.x * gridDim.y * gridDim.z;
    unsigned sum, cnt, mine, sp = 0u;
    for (;;) {
        sum = 0u; cnt = 0u; mine = 0u;
#pragma unroll
        for (unsigned j = 0; j < 16; ++j) { const unsigned c = xb_ld(&bar[XB_XCNT(j)]); sum += c; cnt += (c > 0u) ? 1u : 0u; mine = (j == x) ? c : mine; }
        if (sum == G) break;
        __builtin_amdgcn_s_sleep(1);
        if ((++sp & 255u) == 0u) { if (xb_ld(&bar[XB_TMO])) break; if (sp > XB_SPIN_CAP) { atomicAdd(&bar[XB_TMO], 1u); break; } }
    }
    nloc = mine > 0u ? mine : 1u; nx = cnt > 0u ? cnt : 1u;
}

__device__ __forceinline__ void xcd_barrier(const XcdBarrier& b) {
    asm volatile("s_waitcnt vmcnt(0)" ::: "memory");
    __syncthreads();
    if (threadIdx.x == 0) {
        unsigned* bar = b.bar;
        __builtin_amdgcn_s_waitcnt(0);
        unsigned nloc = b.st[0], nx = b.st[1];
        if (nloc == 0u) { xcd_barrier_complete(bar, b.x, nloc, nx); b.st[0] = nloc; b.st[1] = nx; }
        const unsigned old = xb_add(&bar[XB_XSUB(b.x)], 1u);
        const unsigned gen = old / nloc;
        if (old + 1u == (gen + 1u) * nloc) {
            __builtin_amdgcn_fence(__ATOMIC_RELEASE, "agent");
            asm volatile("s_waitcnt vmcnt(0)" ::: "memory");
            const unsigned og = xb_add(&bar[XB_TOP], 1u);
            const unsigned tg = og / nx;
            if (og + 1u == (tg + 1u) * nx) xb_add(&bar[XB_TOPGEN], 1u);
            else XB_SPIN(xb_ld(&bar[XB_TOPGEN]) == tg, bar);
            __builtin_amdgcn_fence(__ATOMIC_ACQUIRE, "agent");
            xb_add(&bar[XB_XGEN(b.x)], 1u);
            asm volatile("s_waitcnt vmcnt(0)" ::: "memory");
        } else {
            XB_SPIN(xb_ld(&bar[XB_XGEN(b.x)]) == gen, bar);
            __builtin_amdgcn_fence(__ATOMIC_ACQUIRE, "agent");
            asm volatile("s_waitcnt vmcnt(0)" ::: "memory");
        }
    }
    __syncthreads();
}

#ifndef SUB
#define SUB 0xffu
#endif
#ifndef DRYSUB
#define DRYSUB 0xffu
#endif
#ifndef PROBE
#define PROBE 0
#endif
#ifndef PHMASK
#define PHMASK 0xffffu
#endif
__global__ void __launch_bounds__(NT, 2) hybrid_fwd(Prm p) {
    extern __shared__ __attribute__((aligned(16))) unsigned char lds[];
    cg::grid_group grid = cg::this_grid();
    int tid = threadIdx.x, lane = tid & 63, wave = __builtin_amdgcn_readfirstlane(tid >> 6);
    const int G = gridDim.x, wg = blockIdx.x, NGW = G * 8; int gw = wg * 8 + wave;
#define RELAUNDER_IDS() do { tid = threadIdx.x; asm volatile("" : "+v"(tid)); lane = tid & 63; wave = __builtin_amdgcn_readfirstlane(tid >> 6); gw = wg * 8 + wave; } while (0)
    unsigned char* ws = p.ws;
    __attribute__((address_space(3))) unsigned char* lds3 = (__attribute__((address_space(3))) unsigned char*)lds;
    bf16_t* xb = (bf16_t*)(ws + WS_XB); bf16_t* big = (bf16_t*)(ws + WS_BIG);
    float* ss0 = (float*)(ws + WS_SS); float* ss1 = (float*)(ws + WS_SS + SS_STRIDE); float* ss2 = (float*)(ws + WS_SS + 2 * SS_STRIDE);
    float* ss3 = (float*)(ws + WS_SS + 3 * SS_STRIDE); float* ss4 = (float*)(ws + WS_SS + 4 * SS_STRIDE);
    float* xo = p.out;
    unsigned* ctl = (unsigned*)(ws + WS_CTL);
    volatile LAS unsigned* xst = (volatile LAS unsigned*)(lds3 + 163824);
    if (tid == 0) { xst[0] = 0u; xst[1] = 0u; }
    __syncthreads();
    XcdBarrier xbar = xcd_barrier_post(ctl + 4096, xst);

    if (PHMASK & (1u << 0))
    phase0(p, lds, wave, lane, gw, NGW);
    asm volatile("s_waitcnt vmcnt(0) lgkmcnt(0)" ::: "memory"); __syncthreads();
    grid.sync();
    RELAUNDER_IDS();
    if (PHMASK & (1u << 1))
    for (int rep1 = (PROBE & 2) ? 0 : 1; rep1 < 2; ++rep1)
    {
        pg8::Gemm g{xb, (const bf16_t*)(ws + WS_WGU1), MT, 2 * DFF, DM, DM}; pg8::StaticOrder S; S.init(MT, 2 * DFF, G, wg);
        pg8::EpiSwiglu E{big, DFF, ss0};
        pg8::gemm_phase<pg8::EpiSwiglu, pg8::StaticOrder, true, true>(lds3, g, S, E);
    }
    asm volatile("s_waitcnt vmcnt(0) lgkmcnt(0)" ::: "memory"); __syncthreads();
    xcd_barrier(xbar);
    RELAUNDER_IDS();
    if (PHMASK & (1u << 2))
    {
        pg8::Gemm g{big, (const bf16_t*)(ws + WS_WD1), MT, DM, DFF, DFF}; pg8::StaticOrder S; S.init(MT, DM, G, wg);
        pg8::EpiRes E{p.in[0], p.in[1], xo, xb, ss1, 0.5f};
        pg8::gemm_phase<pg8::EpiRes, pg8::StaticOrder, true, true>(lds3, g, S, E);
        if (wg >= 4) {
            pg8::Gemm g2{(const bf16_t*)(ws + WS_MEMB), (const bf16_t*)(ws + WS_WKV), 8192, 2048, DM, DM}; pg8::StaticOrder S2; S2.init(8192, 2048, G - 4, wg - 4);
            pg8::EpiMemKV E2{p.out + O_PMK, p.out + O_PMV, (bf16_t*)(ws + WS_MEMK), (bf16_t*)(ws + WS_MEMV), (const float*)(ws + WS_SSM)};
            pg8::gemm_phase<pg8::EpiMemKV, pg8::StaticOrder, true, true>(lds3, g2, S2, E2);
        }
    }
    asm volatile("s_waitcnt vmcnt(0) lgkmcnt(0)" ::: "memory"); __syncthreads();
    xcd_barrier(xbar);
    RELAUNDER_IDS();
    if (PHMASK & (1u << 3))
    {
        pg8::Gemm g{xb, (const bf16_t*)(ws + WS_WIN), MT, NPJ, DM, DM}; pg8::StaticOrder S; S.init(MT, NPJ, G, wg);
        pg8::EpiScale E{big, NPJ, ss1, 1.0f};
        pg8::gemm_phase<pg8::EpiScale, pg8::StaticOrder, true, true>(lds3, g, S, E);
        if (SUB & 32) bd_pass(p, lds, tid, wave, lane, gw, NGW);
    }
    asm volatile("s_waitcnt vmcnt(0) lgkmcnt(0)" ::: "memory"); __syncthreads();
    xcd_barrier(xbar);
    RELAUNDER_IDS();
    if (PHMASK & (1u << 4))
    for (int rep = (PROBE & 1) ? 0 : 1; rep < 2; ++rep)
    {
        const bool dry = (rep == 0);
        RELAUNDER_IDS();
        const unsigned SUBM = dry ? (unsigned)DRYSUB : (unsigned)SUB;
        if (wg < 128) { if (SUBM & 1) dn_prompt(p, lds, tid, wave, lane, wg >> 2, wg & 3, dry); }
        else {
            if (SUBM & 2) copy_caches(p, wave, lane, wg - 128, G - 128);
            if (wg < 192) { const int u = wg - 128; if (SUBM & 4) dn_sample(p, lds, tid, wave, lane, u >> 2, u & 3, dry); }
            else { for (int u = wg - 192; u < 128; u += (G - 192)) if (SUBM & 8) attn_sample(p, lds, tid, wave, lane, u >> 3, u & 7, dry); }
        }
        __syncthreads();
        for (int i = tid; i < 8 * 257; i += NT) ((float*)(lds + AT_BIAS))[i] = p.in[15][i] * LOG2E;
        __syncthreads();
        for (;;) {
            int u = 0;
            if (lane == 0) u = (int)atomicAdd(ctl + rep, 1u);
            u = __builtin_amdgcn_readfirstlane(u);
            if (u >= 16384) break;
            if (SUBM & 16) { const int half_ = u & 1, c_ = (u >> 1) & 31, h_ = (u >> 6) & 7, b_ = u >> 9;
                attn_unit(p, lds, wave, lane, b_ * 512 + c_ * 16 + h_ * 2 + half_, dry); }
        }
        __syncthreads();
    }
    asm volatile("s_waitcnt vmcnt(0) lgkmcnt(0)" ::: "memory"); __syncthreads();
    xcd_barrier(xbar);
    RELAUNDER_IDS();
    if (PHMASK & (1u << 5))
    {
        pg8::Gemm g{big, (const bf16_t*)(ws + WS_WBA), MT, DM, 512, NPJ}; pg8::StaticOrder S; S.init(MT, DM, G, wg);
        pg8::EpiBranch<0> E{big, 3584};
        pg8::gemm_phase<pg8::EpiBranch<0>, pg8::StaticOrder, true, true>(lds3, g, S, E);
        pg8::Gemm g2{big + 3072, (const bf16_t*)(ws + WS_WBB), MT, DM, 512, NPJ};
        pg8::EpiBranch<1> E2{big, 4608};
        pg8::gemm_phase<pg8::EpiBranch<1>, pg8::StaticOrder, true, true>(lds3, g2, S, E2);
    }
    asm volatile("s_waitcnt vmcnt(0) lgkmcnt(0)" ::: "memory"); __syncthreads();
    xcd_barrier(xbar);
    RELAUNDER_IDS();
    if (PHMASK & (1u << 6))
    {
        pg8::Gemm g{big + 512, (const bf16_t*)(ws + WS_WMIX), MT, DM, DM, NPJ}; pg8::StaticOrder S; S.init(MT, DM, G, wg);
        pg8::EpiRes E{xo, xo + (size_t)MP * DM, xo, xb, ss2, 1.0f};
        pg8::gemm_phase<pg8::EpiRes, pg8::StaticOrder, true, true>(lds3, g, S, E);
    }
    asm volatile("s_waitcnt vmcnt(0) lgkmcnt(0)" ::: "memory"); __syncthreads();
    xcd_barrier(xbar);
    RELAUNDER_IDS();
    if (PHMASK & (1u << 7))
    {
        pg8::Gemm g{xb, (const bf16_t*)(ws + WS_WQ), MT, DM, DM, DM}; pg8::StaticOrder S; S.init(MT, DM, G, wg);
        pg8::EpiScale E{(bf16_t*)(ws + WS_QX), DM, ss2, 0.0625f * LOG2E};
        pg8::gemm_phase<pg8::EpiScale, pg8::StaticOrder, true, true>(lds3, g, S, E);
    }
    asm volatile("s_waitcnt vmcnt(0) lgkmcnt(0)" ::: "memory"); __syncthreads();
    xcd_barrier(xbar);
    RELAUNDER_IDS();
    if (PHMASK & (1u << 8))
    {
        const bf16_t* qx = (const bf16_t*)(ws + WS_QX); bf16_t* ox = (bf16_t*)(ws + WS_OX);
        const bf16_t* memk = (const bf16_t*)(ws + WS_MEMK); const bf16_t* memv = (const bf16_t*)(ws + WS_MEMV);
        for (int bh = wg >> 1; bh < 128; bh += (G >> 1)) {
            const int b = bh >> 2, h = bh & 3;
            xattn_stage_v(memv, lds, tid, (size_t)b * 256, h);
            for (int qi = 0; qi < 4; ++qi) { const int qt = (wg & 1) * 4 + qi;
                for (int dh = 0; dh < 2; ++dh) xattn_unit_k(qx, memk, ox, lds, tid, lane, (size_t)b * 2048 + qt * 256 + wave * 32, (size_t)b * 256, h, 32, dh); }
        }
        for (int u = wg; u < 64; u += G) {
            const int b = u >> 2, h = u & 3;
            xattn_stage_v(memv, lds, tid, (size_t)8192 + b * 256, h);
            for (int dh = 0; dh < 2; ++dh) xattn_unit_k(qx, memk, ox, lds, tid, lane, (size_t)MP + b * 16, (size_t)8192 + b * 256, h, wave == 0 ? 16 : 0, dh);
        }
        __syncthreads();
    }
    asm volatile("s_waitcnt vmcnt(0) lgkmcnt(0)" ::: "memory"); __syncthreads();
    xcd_barrier(xbar);
    RELAUNDER_IDS();
    if (PHMASK & (1u << 9))
    {
        pg8::Gemm g{(const bf16_t*)(ws + WS_OX), (const bf16_t*)(ws + WS_WO), MT, DM, DM, DM}; pg8::StaticOrder S; S.init(MT, DM, G, wg);
        pg8::EpiRes E{xo, xo + (size_t)MP * DM, xo, xb, ss3, 1.0f};
        pg8::gemm_phase<pg8::EpiRes, pg8::StaticOrder, true, true>(lds3, g, S, E);
    }
    asm volatile("s_waitcnt vmcnt(0) lgkmcnt(0)" ::: "memory"); __syncthreads();
    xcd_barrier(xbar);
    RELAUNDER_IDS();
    if (PHMASK & (1u << 10))
    {
        pg8::Gemm g{xb, (const bf16_t*)(ws + WS_WGU2), MT, 2 * DFF, DM, DM}; pg8::StaticOrder S; S.init(MT, 2 * DFF, G, wg);
        pg8::EpiSwiglu E{big, DFF, ss3};
        pg8::gemm_phase<pg8::EpiSwiglu, pg8::StaticOrder, true, true>(lds3, g, S, E);
    }
    asm volatile("s_waitcnt vmcnt(0) lgkmcnt(0)" ::: "memory"); __syncthreads();
    xcd_barrier(xbar);
    RELAUNDER_IDS();
    if (PHMASK & (1u << 11))
    {
        pg8::Gemm g{big, (const bf16_t*)(ws + WS_WD2), MT, DM, DFF, DFF}; pg8::StaticOrder S; S.init(MT, DM, G, wg);
        pg8::EpiRes E{xo, xo + (size_t)MP * DM, xo, nullptr, ss4, 0.5f};
        pg8::gemm_phase<pg8::EpiRes, pg8::StaticOrder, true, true>(lds3, g, S, E);
    }
    asm volatile("s_waitcnt vmcnt(0) lgkmcnt(0)" ::: "memory"); __syncthreads();
    xcd_barrier(xbar);
    RELAUNDER_IDS();
    if (PHMASK & (1u << 12))
    for (int m = gw; m < MT; m += NGW) {
        const float rs = pg8::rstd16(ss4, m);
        f32x4* xr = (f32x4*)(xo + (size_t)m * DM) + lane; const f32x4* gr = (const f32x4*)p.in[33] + lane;
#pragma unroll
        for (int j = 0; j < 4; ++j) { const f32x4 v = xr[64 * j], gg = gr[64 * j]; xr[64 * j] = v * rs * gg; }
    }
}

extern "C" void kernel_launch(void* const* d_in, const int* in_sizes, int n_in, void* d_out, int out_size, void* d_ws, size_t ws_size, hipStream_t stream) {
    static int grid = 0;
    if (grid == 0) {
        if (n_in != 34 || (size_t)out_size != O_END || ws_size < WS_END) { fprintf(stderr, "kernel_launch: unexpected shapes: n_in %d out %d ws %zu (need %zu)\n", n_in, out_size, ws_size, (size_t)WS_END); grid = -1; return; }
        int dev = 0, cus = 0, per_cu = 0;
        hipGetDevice(&dev); hipDeviceGetAttribute(&cus, hipDeviceAttributeMultiprocessorCount, dev);
        if (hipFuncSetAttribute((const void*)hybrid_fwd, hipFuncAttributeMaxDynamicSharedMemorySize, LDS_BYTES) != hipSuccess) { fprintf(stderr, "kernel_launch: hipFuncSetAttribute failed\n"); grid = -1; return; }
        if (hipOccupancyMaxActiveBlocksPerMultiprocessor(&per_cu, (const void*)hybrid_fwd, NT, LDS_BYTES) != hipSuccess || per_cu < 1) { fprintf(stderr, "kernel_launch: occupancy query says %d\n", per_cu); per_cu = 1; }
        (void)hipGetLastError();
        grid = cus;
        if (grid < 192 || (grid & 1)) { fprintf(stderr, "kernel_launch: unsupported CU count %d\n", grid); grid = -1; return; }
    }
    if (grid < 0) return;
    hipMemsetAsync((char*)d_ws + WS_CTL, 0, 65536, stream);
    Prm prm{};
    for (int i = 0; i < 34; ++i) prm.in[i] = (const float*)d_in[i];
    prm.out = (float*)d_out; prm.ws = (unsigned char*)d_ws;
    void* args[] = {&prm};
    hipError_t e = hipLaunchCooperativeKernel((const void*)hybrid_fwd, dim3(grid), dim3(NT), args, LDS_BYTES, stream);
    if (e != hipSuccess) fprintf(stderr, "kernel_launch: cooperative launch failed: %s (grid %d)\n", hipGetErrorString(e), grid);
}
```
